# Optimizing an MI355X kernel written in HIP

```python
import math
import jax, jax.numpy as jnp
from jax import lax
import numpy as np

D_MODEL = 1024
BATCH = 2
SEQ = 8192
DEPTH = 2

D_FF = 2816
HALF_STEP = 0.5
S5_WIDTH = D_MODEL // 2
S5_GROUP = 16
S5_GROUPS = S5_WIDTH // S5_GROUP
S5_STATE = 64
FOX_HEADS = 8
FOX_HEAD_DIM = 64
MLA_HEADS = 8
MLA_Q_RANK = 384
MLA_KV_RANK = 256
MLA_NOPE_DIM = 64
MLA_ROPE_DIM = 32
MLA_V_DIM = 64
ROPE_THETA = 10000.0
NSA_HEADS = 8
NSA_KV_HEADS = 2
NSA_GROUP = NSA_HEADS // NSA_KV_HEADS
NSA_HEAD_DIM = 64
CMP_LEN = 32
CMP_STRIDE = 16
CMP_HIDDEN = 128
SLC_LEN = 64
SLC_TOPK = 16
WINDOW = 512
FORCED_SCORE = 1e4
REL_BUCKETS = 32
REL_MAX_DIST = 128
Q_BLOCK = 128
NEG_INF = -1e30
EPS = 1e-6
EVEN_IN = S5_WIDTH + 3 * FOX_HEADS * FOX_HEAD_DIM + FOX_HEADS
EVEN_OUT = S5_WIDTH + FOX_HEADS * FOX_HEAD_DIM
ODD_IN = MLA_Q_RANK + MLA_KV_RANK + MLA_ROPE_DIM + NSA_HEADS * NSA_HEAD_DIM + 6 * NSA_KV_HEADS * NSA_HEAD_DIM + 3 * NSA_HEADS
ODD_OUT = MLA_HEADS * MLA_V_DIM + NSA_HEADS * NSA_HEAD_DIM

kernel_name = 'hybrid_s5_fox_mla_nsa_macaron'


def _rmsnorm(x, g):
    xf = x.astype(jnp.float32)
    y = xf * lax.rsqrt(jnp.mean(xf * xf, axis=-1, keepdims=True) + EPS)
    return (y * g.astype(jnp.float32)).astype(x.dtype)


def _swiglu(h, w_gate, w_up, w_down):
    return (jax.nn.silu(h @ w_gate) * (h @ w_up)) @ w_down


def _split(x, sizes):
    return jnp.split(x, np.cumsum(sizes)[:-1].tolist(), axis=-1)


def _masked_softmax(s, mask):
    s = jnp.where(mask, s, NEG_INF)
    m = jnp.max(s, axis=-1, keepdims=True)
    p = jnp.where(mask, jnp.exp(s - m), 0.0)
    return p / jnp.maximum(jnp.sum(p, axis=-1, keepdims=True), 1e-30)


def _sweep_query_blocks(fn, seq_len):
    starts = jnp.arange(seq_len // Q_BLOCK, dtype=jnp.int32) * Q_BLOCK
    out = lax.map(fn, starts)
    out = jnp.moveaxis(out, 0, -3)
    return out.reshape(out.shape[:-3] + (seq_len, out.shape[-1]))


def _dense_causal_attention(q, k, v, logit_bias_fn=None):
    seq_len = q.shape[2]
    scale = q.shape[-1] ** -0.5
    kpos = jnp.arange(seq_len)

    def block(q0):
        qb = lax.dynamic_slice_in_dim(q, q0, Q_BLOCK, axis=2)
        s = jnp.einsum('bhqd,bhkd->bhqk', qb, k).astype(jnp.float32) * scale
        if logit_bias_fn is not None:
            s = s + logit_bias_fn(q0)
        qpos = q0 + jnp.arange(Q_BLOCK)
        p = _masked_softmax(s, kpos[None, :] <= qpos[:, None])
        return jnp.einsum('bhqk,bhkd->bhqd', p.astype(v.dtype), v)

    return _sweep_query_blocks(block, seq_len)


def _rope(x, pos):
    half = x.shape[-1] // 2
    freqs = ROPE_THETA ** (-jnp.arange(half, dtype=jnp.float32) / half)
    ang = pos.astype(jnp.float32)[:, None] * freqs[None, :]
    cos = jnp.cos(ang)[None, :, None, :]
    sin = jnp.sin(ang)[None, :, None, :]
    xf = x.astype(jnp.float32)
    x1, x2 = xf[..., :half], xf[..., half:]
    return jnp.concatenate([x1 * cos - x2 * sin, x2 * cos + x1 * sin], axis=-1).astype(x.dtype)


def _t5_bucket(dist):
    n = jnp.maximum(dist, 0)
    max_exact = REL_BUCKETS // 2
    large = max_exact + (jnp.log(jnp.maximum(n, max_exact).astype(jnp.float32) / max_exact)
                         / math.log(REL_MAX_DIST / max_exact) * (REL_BUCKETS - max_exact)).astype(jnp.int32)
    large = jnp.minimum(large, REL_BUCKETS - 1)
    return jnp.where(n < max_exact, n, large)


def _t5_bias(rel_bias, dist):
    tbl = rel_bias.astype(jnp.float32).reshape(REL_BUCKETS, NSA_KV_HEADS, NSA_GROUP).transpose(1, 0, 2)
    b = tbl[jnp.arange(NSA_KV_HEADS)[:, None, None], _t5_bucket(dist)]
    return jnp.moveaxis(b, -1, -3)


def _s5_combine(e1, e2):
    a1r, a1i, b1r, b1i = e1
    a2r, a2i, b2r, b2i = e2
    return (a2r * a1r - a2i * a1i, a2r * a1i + a2i * a1r,
            a2r * b1r - a2i * b1i + b2r, a2r * b1i + a2i * b1r + b2i)


def _s5_glu(u, lam_re, lam_im, log_dt, b_re, b_im, c_re, c_im, d_skip, w_glu, b_glu):
    bsz, seq_len, _ = u.shape
    f32 = jnp.float32
    uf = u.astype(f32)
    ug = uf.reshape(bsz, seq_len, S5_GROUPS, S5_GROUP)
    lr, li = lam_re.astype(f32), lam_im.astype(f32)
    dt = jnp.exp(log_dt.astype(f32))[:, None]
    mag = jnp.exp(lr * dt)
    ar, ai = mag * jnp.cos(li * dt), mag * jnp.sin(li * dt)
    den = lr * lr + li * li
    nr, ni = ar - 1.0, ai
    fr = (nr * lr + ni * li) / den
    fi = (ni * lr - nr * li) / den
    br, bi = b_re.astype(f32), b_im.astype(f32)
    bbr = fr[..., None] * br - fi[..., None] * bi
    bbi = fr[..., None] * bi + fi[..., None] * br
    bu_r = jnp.einsum('btgc,gpc->btgp', ug, bbr)
    bu_i = jnp.einsum('btgc,gpc->btgp', ug, bbi)
    a_r = jnp.broadcast_to(ar, bu_r.shape)
    a_i = jnp.broadcast_to(ai, bu_i.shape)
    _, _, xr, xi = lax.associative_scan(_s5_combine, (a_r, a_i, bu_r, bu_i), axis=1)
    y = (jnp.einsum('btgp,gcp->btgc', xr, c_re.astype(f32))
         - jnp.einsum('btgp,gcp->btgc', xi, c_im.astype(f32)))
    y = y.reshape(bsz, seq_len, S5_WIDTH) + d_skip.astype(f32) * uf
    hg = jax.nn.gelu(y)
    out = hg * jax.nn.sigmoid(hg @ w_glu.astype(f32) + b_glu.astype(f32))
    return out.astype(u.dtype)


def _fox_attention(q, k, v, f_logit, b_f):
    bsz, _, seq_len, _ = q.shape
    log_f = jax.nn.log_sigmoid(f_logit.astype(jnp.float32) + b_f.astype(jnp.float32))
    cum = jnp.cumsum(log_f, axis=1).transpose(0, 2, 1)

    def decay_bias(q0):
        cq = lax.dynamic_slice_in_dim(cum, q0, Q_BLOCK, axis=2)
        return cq[..., :, None] - cum[..., None, :]

    o = _dense_causal_attention(q, k, v, decay_bias)
    return o.transpose(0, 2, 1, 3).reshape(bsz, seq_len, FOX_HEADS * FOX_HEAD_DIM)


def _even_mixer(h, w_in, lam_re, lam_im, log_dt, b_re, b_im, c_re, c_im, d_skip, w_glu, b_glu, fox_b_f, w_out):
    bsz, seq_len, _ = h.shape
    fw = FOX_HEADS * FOX_HEAD_DIM
    u, q, k, v, f_logit = _split(h @ w_in, [S5_WIDTH, fw, fw, fw, FOX_HEADS])
    y_s5 = _s5_glu(u, lam_re, lam_im, log_dt, b_re, b_im, c_re, c_im, d_skip, w_glu, b_glu)

    def heads(t):
        return t.reshape(bsz, seq_len, FOX_HEADS, FOX_HEAD_DIM).transpose(0, 2, 1, 3)

    y_fox = _fox_attention(heads(q), heads(k), heads(v), f_logit, fox_b_f)
    return jnp.concatenate([y_s5, y_fox.astype(y_s5.dtype)], axis=-1) @ w_out


def _nsa(q, k_cmp_raw, v_cmp_raw, k_slc, v_slc, k_win, v_win, gate_logit, b_gate,
         pe_k, pe_v, k_w1, k_w2, v_w1, v_w2, rel_bias):
    bsz, seq_len, _ = q.shape
    G, R, dh = NSA_KV_HEADS, NSA_GROUP, NSA_HEAD_DIM
    scale = dh ** -0.5
    qh = q.reshape(bsz, seq_len, G, R, dh).transpose(0, 2, 3, 1, 4)

    def kv_heads(t):
        return t.reshape(bsz, seq_len, G, dh).transpose(0, 2, 1, 3)

    k_cmp_raw, v_cmp_raw, k_slc, v_slc, k_win, v_win = [
        kv_heads(t) for t in (k_cmp_raw, v_cmp_raw, k_slc, v_slc, k_win, v_win)]
    gates = jax.nn.sigmoid(gate_logit.astype(jnp.float32) + b_gate.astype(jnp.float32))
    gates = gates.reshape(bsz, seq_len, G, R, 3).transpose(0, 2, 3, 1, 4)

    n_cmp = (seq_len - CMP_LEN) // CMP_STRIDE + 1
    cmp_idx = np.arange(n_cmp)[:, None] * CMP_STRIDE + np.arange(CMP_LEN)[None, :]

    def compress(t, pe, w1, w2):
        blk = t[:, :, cmp_idx, :] + pe
        return jax.nn.gelu(blk.reshape(bsz, G, n_cmp, CMP_LEN * dh) @ w1) @ w2

    k_c = compress(k_cmp_raw, pe_k, k_w1, k_w2)
    v_c = compress(v_cmp_raw, pe_v, v_w1, v_w2)
    cmp_end = jnp.arange(n_cmp) * CMP_STRIDE + CMP_LEN - 1

    n_slc = seq_len // SLC_LEN
    ratio = SLC_LEN // CMP_STRIDE
    n_sel = min(SLC_TOPK, n_slc)
    k_sb = k_slc.reshape(bsz, G, n_slc, SLC_LEN, dh)
    v_sb = v_slc.reshape(bsz, G, n_slc, SLC_LEN, dh)
    slc_ids = jnp.arange(n_slc)
    gather_blocks = jax.vmap(jax.vmap(lambda blocks, ids: blocks[ids]))

    pad = ((0, 0), (0, 0), (WINDOW, 0), (0, 0))
    k_wp = jnp.pad(k_win, pad)
    v_wp = jnp.pad(v_win, pad)

    def block(q0):
        qb = lax.dynamic_slice_in_dim(qh, q0, Q_BLOCK, axis=3)
        qpos = q0 + jnp.arange(Q_BLOCK)
        s = jnp.einsum('bgrqd,bgnd->bgrqn', qb, k_c).astype(jnp.float32) * scale
        s = s + _t5_bias(rel_bias, qpos[:, None] - cmp_end[None, :])
        p_c = _masked_softmax(s, cmp_end[None, :] <= qpos[:, None])
        o_c = jnp.einsum('bgrqn,bgnd->bgrqd', p_c.astype(v_c.dtype), v_c)
        imp = jnp.pad(p_c.sum(axis=2), ((0, 0), (0, 0), (0, 0), (0, n_slc * ratio - n_cmp)))
        imp = imp.reshape(bsz, G, Q_BLOCK, n_slc, ratio)
        straddle = jnp.pad(imp[..., :-1, ratio - 1], ((0, 0), (0, 0), (0, 0), (1, 0)))
        imp = imp.sum(axis=-1) + straddle
        cur = (qpos // SLC_LEN)[:, None]
        forced = (slc_ids[None, :] == 0) | (slc_ids[None, :] == cur) | (slc_ids[None, :] == cur - 1)
        imp = jnp.where(slc_ids[None, :] > cur, NEG_INF, jnp.where(forced, imp + FORCED_SCORE, imp))
        vals, idx = lax.top_k(imp, n_sel)
        valid = vals > 0.5 * NEG_INF
        flat = idx.reshape(bsz, G, Q_BLOCK * n_sel)
        kg = gather_blocks(k_sb, flat).reshape(bsz, G, Q_BLOCK, n_sel * SLC_LEN, dh)
        vg = gather_blocks(v_sb, flat).reshape(bsz, G, Q_BLOCK, n_sel * SLC_LEN, dh)
        kpos = (idx[..., None] * SLC_LEN + jnp.arange(SLC_LEN)).reshape(bsz, G, Q_BLOCK, n_sel * SLC_LEN)
        smask = jnp.repeat(valid, SLC_LEN, axis=-1) & (kpos <= qpos[:, None])
        s = jnp.einsum('bgrqd,bgqkd->bgrqk', qb, kg).astype(jnp.float32) * scale
        s = s + _t5_bias(rel_bias, qpos[:, None] - kpos)
        p_s = _masked_softmax(s, smask[:, :, None])
        o_s = jnp.einsum('bgrqk,bgqkd->bgrqd', p_s.astype(vg.dtype), vg)
        kw = lax.dynamic_slice_in_dim(k_wp, q0, Q_BLOCK + WINDOW, axis=2)
        vw = lax.dynamic_slice_in_dim(v_wp, q0, Q_BLOCK + WINDOW, axis=2)
        wpos = q0 - WINDOW + jnp.arange(Q_BLOCK + WINDOW)
        dist = qpos[:, None] - wpos[None, :]
        wmask = (wpos[None, :] >= 0) & (dist >= 0) & (dist < WINDOW)
        s = jnp.einsum('bgrqd,bgkd->bgrqk', qb, kw).astype(jnp.float32) * scale
        s = s + _t5_bias(rel_bias, dist)
        p_w = _masked_softmax(s, wmask)
        o_w = jnp.einsum('bgrqk,bgkd->bgrqd', p_w.astype(vw.dtype), vw)
        g = lax.dynamic_slice_in_dim(gates, q0, Q_BLOCK, axis=3)
        return g[..., 0:1] * o_c + g[..., 1:2] * o_s + g[..., 2:3] * o_w

    o = _sweep_query_blocks(block, seq_len)
    return o.transpose(0, 3, 1, 2, 4).reshape(bsz, seq_len, NSA_HEADS * dh).astype(q.dtype)


def _odd_mixer(h, w_in, q_norm, w_uq, kv_norm, w_ukv, pe_k, pe_v, k_w1, k_w2, v_w1, v_w2, b_gate, w_out, rel_bias):
    bsz, seq_len, _ = h.shape
    pos = jnp.arange(seq_len, dtype=jnp.int32)
    kvw = NSA_KV_HEADS * NSA_HEAD_DIM
    c_q, c_kv, k_rope, q_n, k_c, v_c, k_s, v_s, k_w, v_w, g_logit = _split(
        h @ w_in, [MLA_Q_RANK, MLA_KV_RANK, MLA_ROPE_DIM, NSA_HEADS * NSA_HEAD_DIM,
                   kvw, kvw, kvw, kvw, kvw, kvw, 3 * NSA_HEADS])
    q = (_rmsnorm(c_q, q_norm) @ w_uq).reshape(bsz, seq_len, MLA_HEADS, MLA_NOPE_DIM + MLA_ROPE_DIM)
    q = jnp.concatenate([q[..., :MLA_NOPE_DIM], _rope(q[..., MLA_NOPE_DIM:], pos)], axis=-1)
    kv = (_rmsnorm(c_kv, kv_norm) @ w_ukv).reshape(bsz, seq_len, MLA_HEADS, MLA_NOPE_DIM + MLA_V_DIM)
    k_r = jnp.broadcast_to(_rope(k_rope[:, :, None, :], pos), (bsz, seq_len, MLA_HEADS, MLA_ROPE_DIM))
    k = jnp.concatenate([kv[..., :MLA_NOPE_DIM], k_r], axis=-1)
    v = kv[..., MLA_NOPE_DIM:]
    y_mla = _dense_causal_attention(q.transpose(0, 2, 1, 3), k.transpose(0, 2, 1, 3), v.transpose(0, 2, 1, 3))
    y_mla = y_mla.transpose(0, 2, 1, 3).reshape(bsz, seq_len, MLA_HEADS * MLA_V_DIM)
    y_nsa = _nsa(q_n, k_c, v_c, k_s, v_s, k_w, v_w, g_logit, b_gate, pe_k, pe_v, k_w1, k_w2, v_w1, v_w2, rel_bias)
    return jnp.concatenate([y_mla, y_nsa.astype(y_mla.dtype)], axis=-1) @ w_out


def setup_inputs(seed: int = 0) -> dict:
    key = jax.random.key(seed)
    keys = iter(jax.random.split(key, 128))
    f32 = jnp.float32

    def nrm(shape, scale):
        return scale * jax.random.normal(next(keys), shape, f32)

    def gain(n):
        return 1.0 + 0.05 * jax.random.normal(next(keys), (n,), f32)

    def ffn(d, prefix):
        d[prefix + '_norm'] = gain(D_MODEL)
        d[prefix + '_w_gate'] = nrm((D_MODEL, D_FF), D_MODEL ** -0.5)
        d[prefix + '_w_up'] = nrm((D_MODEL, D_FF), D_MODEL ** -0.5)
        d[prefix + '_w_down'] = nrm((D_FF, D_MODEL), D_FF ** -0.5)

    d = {}
    d['x'] = nrm((BATCH, SEQ, D_MODEL), 1.0)
    d['rel_bias'] = nrm((REL_BUCKETS, NSA_HEADS), 0.5)
    ffn(d, 'l0_ffn1')
    d['l0_mix_norm'] = gain(D_MODEL)
    d['l0_w_in'] = nrm((D_MODEL, EVEN_IN), D_MODEL ** -0.5)
    d['l0_s5_lambda_re'] = -0.5 + nrm((S5_GROUPS, S5_STATE), 0.01)
    d['l0_s5_lambda_im'] = jnp.pi * jnp.arange(S5_STATE, dtype=f32)[None, :] + nrm((S5_GROUPS, S5_STATE), 0.01)
    d['l0_s5_log_dt'] = jax.random.uniform(next(keys), (S5_GROUPS,), f32, math.log(1e-3), math.log(1e-1))
    d['l0_s5_b_re'] = nrm((S5_GROUPS, S5_STATE, S5_GROUP), (2 * S5_GROUP) ** -0.5)
    d['l0_s5_b_im'] = nrm((S5_GROUPS, S5_STATE, S5_GROUP), (2 * S5_GROUP) ** -0.5)
    d['l0_s5_c_re'] = nrm((S5_GROUPS, S5_GROUP, S5_STATE), S5_STATE ** -0.5)
    d['l0_s5_c_im'] = nrm((S5_GROUPS, S5_GROUP, S5_STATE), S5_STATE ** -0.5)
    d['l0_s5_d'] = nrm((S5_WIDTH,), 1.0)
    d['l0_s5_w_glu'] = nrm((S5_WIDTH, S5_WIDTH), S5_WIDTH ** -0.5)
    d['l0_s5_b_glu'] = nrm((S5_WIDTH,), 0.01)
    d['l0_fox_b_f'] = 2.0 + nrm((FOX_HEADS,), 0.5)
    d['l0_w_out'] = nrm((EVEN_OUT, D_MODEL), EVEN_OUT ** -0.5)
    ffn(d, 'l0_ffn2')
    ffn(d, 'l1_ffn1')
    d['l1_mix_norm'] = gain(D_MODEL)
    d['l1_w_in'] = nrm((D_MODEL, ODD_IN), D_MODEL ** -0.5)
    d['l1_mla_q_norm'] = gain(MLA_Q_RANK)
    d['l1_mla_w_uq'] = nrm((MLA_Q_RANK, MLA_HEADS * (MLA_NOPE_DIM + MLA_ROPE_DIM)), MLA_Q_RANK ** -0.5)
    d['l1_mla_kv_norm'] = gain(MLA_KV_RANK)
    d['l1_mla_w_ukv'] = nrm((MLA_KV_RANK, MLA_HEADS * (MLA_NOPE_DIM + MLA_V_DIM)), MLA_KV_RANK ** -0.5)
    d['l1_nsa_cmp_pe_k'] = nrm((CMP_LEN, NSA_HEAD_DIM), 0.1)
    d['l1_nsa_cmp_pe_v'] = nrm((CMP_LEN, NSA_HEAD_DIM), 0.1)
    d['l1_nsa_cmp_k_w1'] = nrm((CMP_LEN * NSA_HEAD_DIM, CMP_HIDDEN), (CMP_LEN * NSA_HEAD_DIM) ** -0.5)
    d['l1_nsa_cmp_k_w2'] = nrm((CMP_HIDDEN, NSA_HEAD_DIM), CMP_HIDDEN ** -0.5)
    d['l1_nsa_cmp_v_w1'] = nrm((CMP_LEN * NSA_HEAD_DIM, CMP_HIDDEN), (CMP_LEN * NSA_HEAD_DIM) ** -0.5)
    d['l1_nsa_cmp_v_w2'] = nrm((CMP_HIDDEN, NSA_HEAD_DIM), CMP_HIDDEN ** -0.5)
    d['l1_nsa_b_gate'] = nrm((3 * NSA_HEADS,), 0.1)
    d['l1_w_out'] = nrm((ODD_OUT, D_MODEL), ODD_OUT ** -0.5)
    ffn(d, 'l1_ffn2')
    d['final_norm'] = gain(D_MODEL)
    return d


def reference(x, rel_bias,
              l0_ffn1_norm, l0_ffn1_w_gate, l0_ffn1_w_up, l0_ffn1_w_down,
              l0_mix_norm, l0_w_in, l0_s5_lambda_re, l0_s5_lambda_im, l0_s5_log_dt,
              l0_s5_b_re, l0_s5_b_im, l0_s5_c_re, l0_s5_c_im, l0_s5_d, l0_s5_w_glu, l0_s5_b_glu,
              l0_fox_b_f, l0_w_out,
              l0_ffn2_norm, l0_ffn2_w_gate, l0_ffn2_w_up, l0_ffn2_w_down,
              l1_ffn1_norm, l1_ffn1_w_gate, l1_ffn1_w_up, l1_ffn1_w_down,
              l1_mix_norm, l1_w_in, l1_mla_q_norm, l1_mla_w_uq, l1_mla_kv_norm, l1_mla_w_ukv,
              l1_nsa_cmp_pe_k, l1_nsa_cmp_pe_v, l1_nsa_cmp_k_w1, l1_nsa_cmp_k_w2,
              l1_nsa_cmp_v_w1, l1_nsa_cmp_v_w2, l1_nsa_b_gate, l1_w_out,
              l1_ffn2_norm, l1_ffn2_w_gate, l1_ffn2_w_up, l1_ffn2_w_down,
              final_norm):
    layers = (
        ((l0_ffn1_norm, l0_ffn1_w_gate, l0_ffn1_w_up, l0_ffn1_w_down),
         (l0_mix_norm, l0_w_in, l0_s5_lambda_re, l0_s5_lambda_im, l0_s5_log_dt, l0_s5_b_re, l0_s5_b_im,
          l0_s5_c_re, l0_s5_c_im, l0_s5_d, l0_s5_w_glu, l0_s5_b_glu, l0_fox_b_f, l0_w_out),
         (l0_ffn2_norm, l0_ffn2_w_gate, l0_ffn2_w_up, l0_ffn2_w_down)),
        ((l1_ffn1_norm, l1_ffn1_w_gate, l1_ffn1_w_up, l1_ffn1_w_down),
         (l1_mix_norm, l1_w_in, l1_mla_q_norm, l1_mla_w_uq, l1_mla_kv_norm, l1_mla_w_ukv,
          l1_nsa_cmp_pe_k, l1_nsa_cmp_pe_v, l1_nsa_cmp_k_w1, l1_nsa_cmp_k_w2,
          l1_nsa_cmp_v_w1, l1_nsa_cmp_v_w2, l1_nsa_b_gate, l1_w_out),
         (l1_ffn2_norm, l1_ffn2_w_gate, l1_ffn2_w_up, l1_ffn2_w_down)),
    )
    h = x
    for i in range(DEPTH):
        ffn1, mix, ffn2 = layers[i]
        h = h + HALF_STEP * _swiglu(_rmsnorm(h, ffn1[0]), *ffn1[1:])
        hn = _rmsnorm(h, mix[0])
        if i % 2 == 0:
            h = h + _even_mixer(hn, *mix[1:])
        else:
            h = h + _odd_mixer(hn, *mix[1:], rel_bias)
        h = h + HALF_STEP * _swiglu(_rmsnorm(h, ffn2[0]), *ffn2[1:])
    return _rmsnorm(h, final_norm)
```

```cpp
#include <hip/hip_runtime.h>
#include <stdint.h>

typedef unsigned short bf16;
typedef float f32x4 __attribute__((ext_vector_type(4)));
typedef short bf16x8 __attribute__((ext_vector_type(8)));
typedef unsigned u32x4 __attribute__((ext_vector_type(4)));

constexpr int NB = 2, S = 8192, T = NB * S, D = 1024, FF = 2816;
constexpr int EVEN_IN = 2056, ODD_IN = 1976, LDW1 = 1984;
constexpr int C_CQ = 0, C_CKV = 384, C_KR = 640, C_QN = 672, C_KC = 1184, C_VC = 1312, C_KS = 1440, C_VS = 1568, C_KW = 1696, C_VW = 1824, C_GL = 1952;

__device__ __forceinline__ bf16 f2bf(float f) { unsigned u = __float_as_uint(f); u += 0x7fffu + ((u >> 16) & 1u); return (bf16)(u >> 16); }
__device__ __forceinline__ float bf2f(bf16 h) { return __uint_as_float(((unsigned)h) << 16); }
__device__ __forceinline__ float bfr(float f) { return bf2f(f2bf(f)); }
__device__ __forceinline__ float sigmoidf_(float x) { return 1.0f / (1.0f + __expf(-x)); }
__device__ __forceinline__ float gelu_tanh(float x) { float u = 0.7978845608028654f * (x + 0.044715f * x * x * x); return 0.5f * x * (1.0f + tanhf(u)); }
__device__ __forceinline__ float log_sigmoid(float x) { return fminf(x, 0.f) - log1pf(__expf(-fabsf(x))); }

struct WS {
    bf16* hb;
    float* rs;
    float* rsq;
    float* rskv;
    bf16* hid;
    float* u0;
    bf16* qkv0;
    bf16* hg;
    float* flog;
    float* cum;
    bf16* ycat;
    bf16* w1o;
    bf16* qmla;
    bf16* kvmla;
    float* ynsa;
    float* imp;
    unsigned* selm;
    float* kcmp;
    float* vcmp;
    bf16* kcb; bf16* vcb; float* s5e;
    bf16* chid;
    float* cb1;
    int* bkt;
};

struct GemmP {
    const bf16* A; int lda; int amode; int acoff;
    const float* W; const float* W2; int ldw; int bmode; int bcoff;
    const float* gain;
    int M, N, K;
};
__device__ __forceinline__ bool a_valid(const GemmP& g, int m) { return g.amode == 0 ? true : ((m & 511) < 511); }
__device__ __forceinline__ const bf16* a_ptr(const GemmP& g, int m, int k) {
    if (g.amode == 0) return g.A + (size_t)m * g.lda + k;
    int bg = m >> 9, i = m & 511, b = bg >> 1, gq = bg & 1, l = k >> 6, d = k & 63;
    return g.A + (size_t)(b * S + 16 * i + l) * g.lda + g.acoff + gq * 64 + d;
}
__device__ __forceinline__ const float* b_col(const GemmP& g, int n) {
    if (g.bmode == 0) return g.W + g.bcoff + n;
    if (g.bmode == 1) { int blk = n >> 4; int j = (n >> 5) * 16 + (n & 15); return ((blk & 1) ? g.W2 : g.W) + j; }
    if (g.bmode == 2) { int hh = n / 96, c = n - hh * 96; if (c < 64) return g.W + n; int r = c - 64; return g.W + hh * 96 + 64 + (r & 1) * 16 + (r >> 1); }
      { if (n >= C_KR && n < C_KR + 32) { int r = n - C_KR; return g.W + C_KR + (r & 1) * 16 + (r >> 1); } return g.W + n; }
}

struct EpiFFN1 {
    bf16* hid; const float* rs;
    __device__ __forceinline__ void quad2(int m, int j0, f32x4 g, f32x4 u) const {
        float r = rs[m]; bf16 o[4];
#pragma unroll
        for (int i = 0; i < 4; ++i) { float gg = g[i] * r, uu = u[i] * r; o[i] = f2bf(gg * sigmoidf_(gg) * uu); }
        *(uint2*)(hid + (size_t)m * FF + j0) = make_uint2(o[0] | ((unsigned)o[1] << 16), o[2] | ((unsigned)o[3] << 16));
    }
};
struct EpiRes {
    const float* hin; float* h; bf16* hb; float scale;
    __device__ __forceinline__ void quad(int m, int n0, f32x4 v) const {
        f32x4 x = *(const f32x4*)(hin + (size_t)m * D + n0); x += v * scale; *(f32x4*)(h + (size_t)m * D + n0) = x;
        *(uint2*)(hb + (size_t)m * D + n0) = make_uint2(f2bf(x[0]) | ((unsigned)f2bf(x[1]) << 16), f2bf(x[2]) | ((unsigned)f2bf(x[3]) << 16));
    }
};
struct EpiWin0 {
    float* u0; bf16* qkv0; float* flog; const float* rs;
    __device__ __forceinline__ void quad(int m, int n0, f32x4 v) const {
        float r = rs[m]; v *= r;
        if (n0 < 512) *(f32x4*)(u0 + (size_t)m * 512 + n0) = v;
        else if (n0 < 2048) *(uint2*)(qkv0 + (size_t)m * 1536 + (n0 - 512)) = make_uint2(f2bf(v[0]) | ((unsigned)f2bf(v[1]) << 16), f2bf(v[2]) | ((unsigned)f2bf(v[3]) << 16));
        else if (n0 < 2056) *(f32x4*)(flog + (size_t)m * 8 + (n0 - 2048)) = v;
    }
};
struct EpiGlu {
    const bf16* hg; const float* bglu; bf16* ycat;
    __device__ __forceinline__ void quad(int m, int n0, f32x4 v) const {
        bf16 o[4];
#pragma unroll
        for (int i = 0; i < 4; ++i) { float hgv = bf2f(hg[(size_t)m * 512 + n0 + i]); o[i] = f2bf(hgv * sigmoidf_(v[i] + bglu[n0 + i])); }
        *(uint2*)(ycat + (size_t)m * D + n0) = make_uint2(o[0] | ((unsigned)o[1] << 16), o[2] | ((unsigned)o[3] << 16));
    }
};
struct EpiWin1 {
    bf16* w1o; const float* rs;
    __device__ __forceinline__ void quad(int m, int n0, f32x4 v) const {
        if (n0 >= ODD_IN) return;
        float r = rs[m]; v *= r;
        if (n0 >= C_KR && n0 < C_KR + 32) {
            int pos = m & (S - 1);
#pragma unroll
            for (int pp = 0; pp < 2; ++pp) { int i = ((n0 - C_KR) >> 1) + pp; float fr = powf(10000.0f, -(float)i / 16.0f); float ang = (float)pos * fr; float c = cosf(ang), s = sinf(ang);
                float x1 = v[2 * pp], x2 = v[2 * pp + 1]; v[2 * pp] = x1 * c - x2 * s; v[2 * pp + 1] = x2 * c + x1 * s; }
        }
        *(uint2*)(w1o + (size_t)m * LDW1 + n0) = make_uint2(f2bf(v[0]) | ((unsigned)f2bf(v[1]) << 16), f2bf(v[2]) | ((unsigned)f2bf(v[3]) << 16));
    }
};
struct EpiUq {
    bf16* qmla; const float* rsq;
    __device__ __forceinline__ void quad(int m, int n0, f32x4 v) const {
        float r = rsq[m]; v *= r; int hh = n0 / 96, c = n0 - hh * 96;
        if (c >= 64) { int pos = m & (S - 1);
#pragma unroll
            for (int pp = 0; pp < 2; ++pp) { int i = ((c - 64) >> 1) + pp; float fr = powf(10000.0f, -(float)i / 16.0f); float ang = (float)pos * fr; float cs = cosf(ang), sn = sinf(ang);
                float x1 = v[2 * pp], x2 = v[2 * pp + 1]; v[2 * pp] = x1 * cs - x2 * sn; v[2 * pp + 1] = x2 * cs + x1 * sn; } }
        *(uint2*)(qmla + (size_t)m * 768 + n0) = make_uint2(f2bf(v[0]) | ((unsigned)f2bf(v[1]) << 16), f2bf(v[2]) | ((unsigned)f2bf(v[3]) << 16));
    }
};
struct EpiUkv {
    bf16* kvmla; const float* rskv;
    __device__ __forceinline__ void quad(int m, int n0, f32x4 v) const {
        float r = rskv[m]; v *= r;
        *(uint2*)(kvmla + (size_t)m * 1024 + n0) = make_uint2(f2bf(v[0]) | ((unsigned)f2bf(v[1]) << 16), f2bf(v[2]) | ((unsigned)f2bf(v[3]) << 16));
    }
};
struct EpiCmp1 {
    bf16* chid; const float* cb1;
    __device__ __forceinline__ void quad(int m, int n0, f32x4 v) const {
        bf16 o[4];
#pragma unroll
        for (int i = 0; i < 4; ++i) o[i] = f2bf(gelu_tanh(v[i] + cb1[n0 + i]));
        *(uint2*)(chid + (size_t)m * 128 + n0) = make_uint2(o[0] | ((unsigned)o[1] << 16), o[2] | ((unsigned)o[3] << 16));
    }
};
struct EpiCmp2 {
    float* out; bf16* outb;
    __device__ __forceinline__ void quad(int m, int n0, f32x4 v) const { if (n0 < 64) { *(f32x4*)(out + (size_t)m * 64 + n0) = v;
        *(uint2*)(outb + (size_t)m * 64 + n0) = make_uint2(f2bf(v[0]) | ((unsigned)f2bf(v[1]) << 16), f2bf(v[2]) | ((unsigned)f2bf(v[3]) << 16)); } }
};

template <class Epi, bool DUAL>
__global__ void __launch_bounds__(256) gemm_naive(GemmP g, Epi e) {
    const int nq = (DUAL ? g.N / 2 : (g.N + 3) / 4 * 4) / 4;
    const long total = (long)g.M * nq;
    for (long idx = (long)blockIdx.x * blockDim.x + threadIdx.x; idx < total; idx += (long)gridDim.x * blockDim.x) {
        const int m = (int)(idx / nq), qd = (int)(idx % nq);
        if constexpr (DUAL) {
            const int j0 = qd * 4; f32x4 ag = {0, 0, 0, 0}, au = {0, 0, 0, 0};
            for (int k = 0; k < g.K; ++k) { float a = bf2f(*a_ptr(g, m, k)); float gn = g.gain ? g.gain[k] : 1.f;
#pragma unroll
                for (int i = 0; i < 4; ++i) { ag[i] += a * bfr(g.W[(size_t)k * g.ldw + j0 + i] * gn); au[i] += a * bfr(g.W2[(size_t)k * g.ldw + j0 + i] * gn); } }
            e.quad2(m, j0, ag, au);
        } else {
            const int n0 = qd * 4; f32x4 acc = {0, 0, 0, 0};
            const float* bc[4]; bool bv[4];
#pragma unroll
            for (int i = 0; i < 4; ++i) { bv[i] = (n0 + i) < g.N; bc[i] = b_col(g, bv[i] ? n0 + i : 0); }
            const bool av = a_valid(g, m);
            for (int k = 0; k < g.K; ++k) { float a = av ? bf2f(*a_ptr(g, m, k)) : 0.f; float gn = g.gain ? g.gain[k] : 1.f;
#pragma unroll
                for (int i = 0; i < 4; ++i) acc[i] += bv[i] ? a * bfr(bc[i][(size_t)k * g.ldw] * gn) : 0.f; }
            e.quad(m, n0, acc);
        }
    }
}

constexpr int G_LDS = 72;
constexpr int G_SMEM = 2 * 128 * G_LDS * 2;
template <class Epi, bool DUAL>
__device__ __forceinline__ void gemm_tile(const GemmP& g, const Epi& e, int tm, int tn, bf16* smem) {
    bf16* As = smem; bf16* Bs = smem + 128 * G_LDS;
    const int tid = threadIdx.x, lane = tid & 63, wave = tid >> 6, wm = wave >> 1, wn = wave & 1;
    const int m0 = tm * 128, n0 = tn * 128;
    const int bn = tid & 127, bkh = tid >> 7;
    const bool bvalid = (n0 + bn) < g.N;
    const float* bcol = b_col(g, bvalid ? n0 + bn : 0);
    uint4 ra[4]; float rb[32];
    const int nkt = g.K / 64;
    auto load_tile = [&](int kt) {
#pragma unroll
        for (int i = 0; i < 4; ++i) { int c = tid + i * 256, row = c >> 3, kc = c & 7; int m = m0 + row;
            ra[i] = a_valid(g, m) ? *(const uint4*)a_ptr(g, m, kt * 64 + kc * 8) : make_uint4(0, 0, 0, 0); }
        const float* bp = bcol + (size_t)(kt * 64 + bkh * 32) * g.ldw;
#pragma unroll
        for (int j = 0; j < 32; ++j) rb[j] = bvalid ? bp[(size_t)j * g.ldw] : 0.f;
        if (g.gain) { const float* gp = g.gain + kt * 64 + bkh * 32;
#pragma unroll
            for (int j = 0; j < 32; ++j) rb[j] *= gp[j]; }
    };
    auto store_tile = [&]() {
#pragma unroll
        for (int i = 0; i < 4; ++i) { int c = tid + i * 256, row = c >> 3, kc = c & 7; *(uint4*)(As + row * G_LDS + kc * 8) = ra[i]; }
#pragma unroll
        for (int q = 0; q < 4; ++q) { uint4 w;
            w.x = f2bf(rb[q * 8 + 0]) | ((unsigned)f2bf(rb[q * 8 + 1]) << 16); w.y = f2bf(rb[q * 8 + 2]) | ((unsigned)f2bf(rb[q * 8 + 3]) << 16);
            w.z = f2bf(rb[q * 8 + 4]) | ((unsigned)f2bf(rb[q * 8 + 5]) << 16); w.w = f2bf(rb[q * 8 + 6]) | ((unsigned)f2bf(rb[q * 8 + 7]) << 16);
            *(uint4*)(Bs + bn * G_LDS + bkh * 32 + q * 8) = w; }
    };
    f32x4 acc[4][4];
#pragma unroll
    for (int i = 0; i < 4; ++i)
#pragma unroll
        for (int j = 0; j < 4; ++j) acc[i][j] = (f32x4){0.f, 0.f, 0.f, 0.f};
    load_tile(0);
    for (int kt = 0; kt < nkt; ++kt) {
        __syncthreads();
        store_tile();
        __syncthreads();
        if (kt + 1 < nkt) load_tile(kt + 1);
#pragma unroll
        for (int kk = 0; kk < 2; ++kk) {
            bf16x8 a[4], b[4];
#pragma unroll
            for (int i = 0; i < 4; ++i) a[i] = *(const bf16x8*)(As + (wm * 64 + i * 16 + (lane & 15)) * G_LDS + kk * 32 + (lane >> 4) * 8);
#pragma unroll
            for (int j = 0; j < 4; ++j) b[j] = *(const bf16x8*)(Bs + (wn * 64 + j * 16 + (lane & 15)) * G_LDS + kk * 32 + (lane >> 4) * 8);
#pragma unroll
            for (int i = 0; i < 4; ++i)
#pragma unroll
                for (int j = 0; j < 4; ++j) acc[i][j] = __builtin_amdgcn_mfma_f32_16x16x32_bf16(b[j], a[i], acc[i][j], 0, 0, 0);
        }
    }
#pragma unroll
    for (int i = 0; i < 4; ++i) { const int m = m0 + wm * 64 + i * 16 + (lane & 15);
        if constexpr (DUAL) {
#pragma unroll
            for (int jj = 0; jj < 2; ++jj) e.quad2(m, tn * 64 + wn * 32 + jj * 16 + (lane >> 4) * 4, acc[i][2 * jj], acc[i][2 * jj + 1]);
        } else {
#pragma unroll
            for (int j = 0; j < 4; ++j) e.quad(m, n0 + wn * 64 + j * 16 + (lane >> 4) * 4, acc[i][j]);
        }
    }
}
template <class Epi, bool DUAL>
__global__ void __launch_bounds__(256) gemm_mfma(GemmP g, Epi e) {
    __shared__ __attribute__((aligned(16))) bf16 smem[2 * 128 * G_LDS];
    const int tilesM = g.M / 128, tilesN = (g.N + 127) / 128, nt = tilesM * tilesN;
    for (int t = blockIdx.x; t < nt; t += gridDim.x) gemm_tile<Epi, DUAL>(g, e, t % tilesM, t / tilesM, smem);
}

__global__ void k_init(const float* x, float* h, bf16* hb) {
    for (long i = (long)blockIdx.x * blockDim.x + threadIdx.x; i < (long)T * D / 4; i += (long)gridDim.x * blockDim.x) {
        f32x4 v = ((const f32x4*)x)[i]; ((f32x4*)h)[i] = v;
        ((uint2*)hb)[i] = make_uint2(f2bf(v[0]) | ((unsigned)f2bf(v[1]) << 16), f2bf(v[2]) | ((unsigned)f2bf(v[3]) << 16));
    }
}
__global__ void k_rownorm_f32(const float* x, int ld, int ncols, float* rs, int rows) {
    int wave = (blockIdx.x * blockDim.x + threadIdx.x) >> 6, lane = threadIdx.x & 63, nw = (gridDim.x * blockDim.x) >> 6;
    for (int r = wave; r < rows; r += nw) { float s = 0.f; for (int c = lane; c < ncols; c += 64) { float v = x[(size_t)r * ld + c]; s += v * v; }
        for (int o = 32; o; o >>= 1) s += __shfl_xor(s, o);
        if (lane == 0) rs[r] = rsqrtf(s / (float)ncols + 1e-6f); }
}
__global__ void k_rownorm_bf(const bf16* x, int ld, int ncols, float* rs, int rows) {
    int wave = (blockIdx.x * blockDim.x + threadIdx.x) >> 6, lane = threadIdx.x & 63, nw = (gridDim.x * blockDim.x) >> 6;
    for (int r = wave; r < rows; r += nw) { float s = 0.f; for (int c = lane; c < ncols; c += 64) { float v = bf2f(x[(size_t)r * ld + c]); s += v * v; }
        for (int o = 32; o; o >>= 1) s += __shfl_xor(s, o);
        if (lane == 0) rs[r] = rsqrtf(s / (float)ncols + 1e-6f); }
}
__global__ void k_final(const float* h, const float* gain, float* out) {
    int wave = (blockIdx.x * blockDim.x + threadIdx.x) >> 6, lane = threadIdx.x & 63, nw = (gridDim.x * blockDim.x) >> 6;
    for (int r = wave; r < T; r += nw) { f32x4 v[4]; float s = 0.f;
#pragma unroll
        for (int i = 0; i < 4; ++i) { v[i] = *(const f32x4*)(h + (size_t)r * D + i * 256 + lane * 4); s += v[i][0] * v[i][0] + v[i][1] * v[i][1] + v[i][2] * v[i][2] + v[i][3] * v[i][3]; }
        for (int o = 32; o; o >>= 1) s += __shfl_xor(s, o);
        float rr = rsqrtf(s / (float)D + 1e-6f);
#pragma unroll
        for (int i = 0; i < 4; ++i) { f32x4 g = *(const f32x4*)(gain + i * 256 + lane * 4); *(f32x4*)(out + (size_t)r * D + i * 256 + lane * 4) = v[i] * rr * g; } }
}
__global__ void k_misc(const float* pe_k, const float* pe_v, const float* k_w1, const float* v_w1, float* cb1, int* bkt) {
    int tid = blockIdx.x * blockDim.x + threadIdx.x;
    if (tid < 256) { int which = tid >> 7, n = tid & 127; const float* pe = which ? pe_v : pe_k; const float* w1 = which ? v_w1 : k_w1; float s = 0.f;
        for (int k = 0; k < 2048; ++k) s += pe[k] * w1[(size_t)k * 128 + n]; cb1[tid] = s; }
    if (tid < 128) { int n = tid, b; if (n < 16) b = n; else { float v = logf((float)n / 16.0f) / 2.0794415416798357f * 16.0f; b = 16 + (int)v; if (b > 31) b = 31; } bkt[n] = b; }
}

__global__ void k_foxcum(const float* flog, const float* bf, float* cum) {
    int w = blockIdx.x, lane = threadIdx.x; int b = w >> 3, h = w & 7; float bb = bf[h];
    int t0 = lane * 128; double s = 0.0;
    for (int i = 0; i < 128; ++i) s += (double)log_sigmoid(flog[(size_t)(b * S + t0 + i) * 8 + h] + bb);
    double incl = s;
    for (int o = 1; o < 64; o <<= 1) { double v = __shfl_up(incl, o); if (lane >= o) incl += v; }
    double run = incl - s;
    for (int i = 0; i < 128; ++i) { run += (double)log_sigmoid(flog[(size_t)(b * S + t0 + i) * 8 + h] + bb); cum[(size_t)(b * S + t0 + i) * 8 + h] = (float)run; }
}

__global__ void __launch_bounds__(64) k_s5_naive(const float* u0, const float* lam_re, const float* lam_im, const float* log_dt, const float* b_re, const float* b_im,
                                                  const float* c_re, const float* c_im, const float* dskip, bf16* hg) {
    __shared__ float xr[64][65], xi[64][65];
    int bg = blockIdx.x, b = bg >> 5, g = bg & 31, p = threadIdx.x;
    float lr = lam_re[g * 64 + p], li = lam_im[g * 64 + p], dt = __expf(log_dt[g]);
    float mag = __expf(lr * dt), ar = mag * cosf(li * dt), ai = mag * sinf(li * dt);
    float den = lr * lr + li * li, nr = ar - 1.0f, ni = ai;
    float fr = (nr * lr + ni * li) / den, fi = (ni * lr - nr * li) / den;
    float bbr[16], bbi[16];
#pragma unroll
    for (int c = 0; c < 16; ++c) { float br = b_re[(g * 64 + p) * 16 + c], bi = b_im[(g * 64 + p) * 16 + c]; bbr[c] = fr * br - fi * bi; bbi[c] = fr * bi + fi * br; }
    float sr = 0.f, si = 0.f;
    for (int t0 = 0; t0 < S; t0 += 64) {
        for (int tt = 0; tt < 64; ++tt) {
            const float* up = u0 + (size_t)(b * S + t0 + tt) * 512 + g * 16; float br_ = 0.f, bi_ = 0.f;
#pragma unroll
            for (int c = 0; c < 16; ++c) { float uv = up[c]; br_ += bbr[c] * uv; bi_ += bbi[c] * uv; }
            float nsr = ar * sr - ai * si + br_, nsi = ar * si + ai * sr + bi_; sr = nsr; si = nsi;
            xr[tt][p] = sr; xi[tt][p] = si;
        }
        __syncthreads();
        int tt = p; float y[16];
#pragma unroll
        for (int c = 0; c < 16; ++c) y[c] = 0.f;
        for (int q = 0; q < 64; ++q) { float a = xr[tt][q], bq = xi[tt][q];
#pragma unroll
            for (int c = 0; c < 16; ++c) y[c] += a * c_re[(g * 16 + c) * 64 + q] - bq * c_im[(g * 16 + c) * 64 + q]; }
        const float* up = u0 + (size_t)(b * S + t0 + tt) * 512 + g * 16;
#pragma unroll
        for (int c = 0; c < 16; ++c) { float v = y[c] + dskip[g * 16 + c] * up[c]; hg[(size_t)(b * S + t0 + tt) * 512 + g * 16 + c] = f2bf(gelu_tanh(v)); }
        __syncthreads();
    }
}

struct AttnP {
    const bf16* q; int ldq; const bf16* k; int ldk; const bf16* v; int ldv; const bf16* k2;
    const float* cum; const float* relb; const int* bkt; const unsigned* selm;
    const bf16* gl; const float* bgate; float* ynsa; bf16* out; int ldo;
    const bf16* kw; const bf16* vw; const bf16* kcb; const bf16* vcb;
};
__device__ __forceinline__ float t5b(const float* relb, const int* bkt, int h, int dist) { int bk = dist < 128 ? bkt[dist] : 31; return relb[bk * 8 + h]; }

template <int MODE>
__global__ void __launch_bounds__(64) k_attn_naive(AttnP p) {
    constexpr int DK = (MODE == 1) ? 96 : 64;
    const int blk = blockIdx.x; const int tb = blk & (S / 64 - 1), bh = blk / (S / 64), b = bh >> 3, h = bh & 7, g = h >> 2;
    const int t0 = tb * 64, t = t0 + threadIdx.x; const size_t row = (size_t)b * S + t;
    float qv[DK], o[64];
    const int qoff = (MODE == 1) ? h * 96 : h * 64;
#pragma unroll
    for (int d = 0; d < DK; ++d) qv[d] = bf2f(p.q[row * p.ldq + qoff + d]);
#pragma unroll
    for (int d = 0; d < 64; ++d) o[d] = 0.f;
    const float scale = (MODE == 1) ? 0.10206207261596577f : 0.125f;
    float m = -1e30f, l = 0.f;
    const float cq = (MODE == 0) ? p.cum[row * 8 + h] : 0.f;
    unsigned long long mlo = 0, mhi = 0;
    if (MODE == 3) { const unsigned* sm = p.selm + (row * 2 + g) * 4; mlo = sm[0] | ((unsigned long long)sm[1] << 32); mhi = sm[2] | ((unsigned long long)sm[3] << 32); }
    const int klo = (MODE == 2) ? (t0 - 511 > 0 ? t0 - 511 : 0) : 0, khi = t0 + 63;
    const int koff = (MODE == 0) ? h * 64 : (MODE == 1) ? h * 128 : g * 64;
    const int voff = (MODE == 1) ? h * 128 + 64 : koff;
    for (int key = klo; key <= khi; ++key) {
        const size_t kr = (size_t)b * S + key;
        const bf16* kp = p.k + kr * p.ldk + koff; float s = 0.f;
#pragma unroll
        for (int d = 0; d < 64; ++d) s += qv[d] * bf2f(kp[d]);
        if (MODE == 1) { const bf16* k2 = p.k2 + kr * LDW1 + C_KR;
#pragma unroll
            for (int d = 0; d < 32; ++d) s += qv[64 + d] * bf2f(k2[d]); }
        s *= scale;
        bool valid = key <= t;
        if (MODE == 0) s += cq - p.cum[kr * 8 + h];
        if (MODE == 2) { valid = valid && (t - key < 512); }
        if (MODE == 3) { int j = key >> 6; bool bit = j < 64 ? ((mlo >> j) & 1ull) : ((mhi >> (j - 64)) & 1ull); valid = valid && bit; }
        if (MODE >= 2) { int dist = t - key; if (dist < 0) dist = 0; s += t5b(p.relb, p.bkt, h, dist); }
        if (valid) {
            float mn = fmaxf(m, s), corr = __expf(m - mn), pe = __expf(s - mn); l = l * corr + pe; m = mn;
            const bf16* vp = p.v + kr * p.ldv + voff;
#pragma unroll
            for (int d = 0; d < 64; ++d) o[d] = o[d] * corr + pe * bf2f(vp[d]);
        }
    }
    const float inv = 1.0f / fmaxf(l, 1e-30f);
    if (MODE <= 1) {
#pragma unroll
        for (int d = 0; d < 64; ++d) p.out[row * p.ldo + h * 64 + d] = f2bf(o[d] * inv);
    } else {
        const int gi = h * 3 + (MODE == 2 ? 2 : 1);
        const float gate = sigmoidf_(bf2f(p.gl[row * LDW1 + C_GL + gi]) + p.bgate[gi]);
#pragma unroll
        for (int d = 0; d < 64; ++d) p.ynsa[row * 512 + h * 64 + d] += gate * o[d] * inv;
    }
}

typedef short s16x4 __attribute__((ext_vector_type(4)));
#define LDS_AS __attribute__((address_space(3)))
constexpr int IMPS = 129;
constexpr int FL_SMEM = 64 * 104 * 2 + 64 * 72 * 2 + 256 + 2048 + 32 * IMPS * 4 + 512;
constexpr float LOG2E = 1.4426950408889634f;
__device__ __forceinline__ unsigned pk2(float a, float b) { return (unsigned)f2bf(a) | ((unsigned)f2bf(b) << 16); }
struct FCtx { int b, hq, hkv, qw0, qb_lo, qb_hi; };

template <int NKS, int KST>
__device__ __forceinline__ void qk_tile(const bf16* Ks, const bf16x8 (&qf)[2][NKS], f32x4 (&sc)[2][4], int l15, int quad) {
#pragma unroll
    for (int qt = 0; qt < 2; ++qt)
#pragma unroll
        for (int kt = 0; kt < 4; ++kt) sc[qt][kt] = (f32x4){0.f, 0.f, 0.f, 0.f};
#pragma unroll
    for (int ks = 0; ks < NKS; ++ks)
#pragma unroll
        for (int kt = 0; kt < 4; ++kt) { const bf16x8 kf = *(const bf16x8*)(Ks + (kt * 16 + l15) * KST + ks * 32 + quad * 8);
#pragma unroll
            for (int qt = 0; qt < 2; ++qt) sc[qt][kt] = __builtin_amdgcn_mfma_f32_16x16x32_bf16(kf, qf[qt][ks], sc[qt][kt], 0, 0, 0); }
}
__device__ __forceinline__ void pv_tile(const bf16* Vs, const unsigned (&pb)[2][4][2], f32x4 (&o)[2][4], int lane) {
    constexpr int VST = 72; const int l15 = lane & 15, quad = lane >> 4;
#pragma unroll
    for (int ks2 = 0; ks2 < 2; ++ks2) {
        bf16x8 pf[2];
#pragma unroll
        for (int qt = 0; qt < 2; ++qt) { const u32x4 t4 = {pb[qt][2 * ks2][0], pb[qt][2 * ks2][1], pb[qt][2 * ks2 + 1][0], pb[qt][2 * ks2 + 1][1]}; pf[qt] = __builtin_bit_cast(bf16x8, t4); }
#pragma unroll
        for (int dvt = 0; dvt < 4; ++dvt) {
            const bf16* a0 = Vs + (ks2 * 32 + quad * 4 + (l15 >> 2)) * VST + dvt * 16 + (lane & 3) * 4;
            const s16x4 v0 = __builtin_amdgcn_ds_read_tr16_b64_v4i16((LDS_AS s16x4*)a0);
            const s16x4 v1 = __builtin_amdgcn_ds_read_tr16_b64_v4i16((LDS_AS s16x4*)(a0 + 16 * VST));
            bf16x8 vf; vf[0] = v0[0]; vf[1] = v0[1]; vf[2] = v0[2]; vf[3] = v0[3]; vf[4] = v1[0]; vf[5] = v1[1]; vf[6] = v1[2]; vf[7] = v1[3];
#pragma unroll
            for (int qt = 0; qt < 2; ++qt) o[qt][dvt] = __builtin_amdgcn_mfma_f32_16x16x32_bf16(vf, pf[qt], o[qt][dvt], 0, 0, 0);
        }
    }
}

template <int MODE>
__device__ __forceinline__ void flash_core(const AttnP& p, const FCtx& c, char* smem, const unsigned (&mw)[2][4], f32x4 (&o)[2][4], float (&linv)[2]) {
    constexpr int DK = (MODE == 1) ? 96 : 64, KST = DK + 8, VST = 72, KCH = DK / 8, NKI = KCH * 64 / 256, NKS = DK / 32;
    bf16* Ks = (bf16*)smem; bf16* Vs = Ks + 64 * 104; float* cks = (float*)(Vs + 64 * VST); float* tb = cks + 64;
    const int tid = threadIdx.x, lane = tid & 63, w = tid >> 6, l15 = lane & 15, quad = lane >> 4;
    const int b = c.b, hq = c.hq, hkv = c.hkv, qw0 = c.qw0;
    const int thi = c.qb_hi >> 6; int tlo = 0;
    if (MODE == 2) { int lo = c.qb_lo - 511; if (lo < 0) lo = 0; tlo = lo >> 6; }
    const float SL = ((MODE == 1) ? 0.10206207261596577f : 0.125f) * LOG2E;
    const size_t rowb = (size_t)b * S;
    const bf16* kp = (MODE == 2) ? p.kw : p.k; const bf16* vp = (MODE == 2) ? p.vw : p.v;
    bf16x8 qf[2][NKS];
    const int qoff = (MODE == 1) ? hq * 96 : hq * 64;
#pragma unroll
    for (int qt = 0; qt < 2; ++qt)
#pragma unroll
        for (int ks = 0; ks < NKS; ++ks) qf[qt][ks] = *(const bf16x8*)(p.q + (rowb + qw0 + qt * 16 + l15) * p.ldq + qoff + ks * 32 + quad * 8);
    float cq[2] = {0.f, 0.f}; float c31 = 0.f;
    if (MODE == 0) { cq[0] = p.cum[(rowb + qw0 + l15) * 8 + hq] * LOG2E; cq[1] = p.cum[(rowb + qw0 + 16 + l15) * 8 + hq] * LOG2E; }
    if (MODE >= 2) c31 = p.relb[31 * 8 + hq] * LOG2E;
    const int koff = (MODE == 0) ? hkv * 64 : (MODE == 1) ? hkv * 128 : hkv * 64;
    const int voff = (MODE == 1) ? hkv * 128 + 64 : koff;
    u32x4 rk[NKI], rv[2]; float rc = 0.f;
#define FL_LOAD(tile_) do { \
        _Pragma("unroll") for (int i = 0; i < NKI; ++i) { const int cc = tid + i * 256, key = cc / KCH, kc = cc % KCH; const size_t row = rowb + (tile_) * 64 + key; \
            const bf16* src = kp + row * p.ldk + koff + kc * 8; \
            if (MODE == 1) { if (kc >= 8) src = p.k2 + row * LDW1 + C_KR + (kc - 8) * 8; } \
            rk[i] = *(const u32x4*)src; } \
        _Pragma("unroll") for (int i = 0; i < 2; ++i) { const int cc = tid + i * 256, key = cc >> 3, vc = cc & 7; rv[i] = *(const u32x4*)(vp + (rowb + (tile_) * 64 + key) * p.ldv + voff + vc * 8); } \
        if (MODE == 0 && tid < 64) rc = p.cum[(rowb + (tile_) * 64 + tid) * 8 + hq] * LOG2E; } while (0)
#define FL_STORE() do { \
        _Pragma("unroll") for (int i = 0; i < NKI; ++i) { const int cc = tid + i * 256, key = cc / KCH, kc = cc % KCH; *(u32x4*)(Ks + key * KST + kc * 8) = rk[i]; } \
        _Pragma("unroll") for (int i = 0; i < 2; ++i) { const int cc = tid + i * 256, key = cc >> 3, vc = cc & 7; *(u32x4*)(Vs + key * VST + vc * 8) = rv[i]; } \
        if (MODE == 0 && tid < 64) cks[tid] = rc; } while (0)
    float m[2] = {-INFINITY, -INFINITY}, l[2] = {0.f, 0.f};
#pragma unroll
    for (int qt = 0; qt < 2; ++qt)
#pragma unroll
        for (int d = 0; d < 4; ++d) o[qt][d] = (f32x4){0.f, 0.f, 0.f, 0.f};
    FL_LOAD(tlo);
    for (int tile = tlo; tile <= thi; ++tile) {
        __syncthreads();
        FL_STORE();
        __syncthreads();
        if (tile < thi) FL_LOAD(tile + 1);
        const int kbase = tile * 64;
        if (kbase > qw0 + 31) continue;
        if (MODE == 2 && kbase + 63 < qw0 - 511) continue;
        f32x4 sc[2][4];
        qk_tile<NKS, KST>(Ks, qf, sc, l15, quad);
        const bool near = (MODE >= 2) && (kbase + 63 >= qw0 - 127);
        f32x4 ckv[4];
        if (MODE == 0) {
#pragma unroll
            for (int kt = 0; kt < 4; ++kt) ckv[kt] = *(const f32x4*)(cks + kt * 16 + quad * 4); }
        unsigned pb[2][4][2];
#pragma unroll
        for (int qt = 0; qt < 2; ++qt) {
            const int q = qw0 + qt * 16 + l15;
            bool bit = true;
            if (MODE == 3) { const unsigned ws_ = (tile < 32) ? mw[qt][0] : (tile < 64) ? mw[qt][1] : (tile < 96) ? mw[qt][2] : mw[qt][3]; bit = (ws_ >> (tile & 31)) & 1u; }
            float mx = -INFINITY;
#pragma unroll
            for (int kt = 0; kt < 4; ++kt)
#pragma unroll
                for (int r = 0; r < 4; ++r) { const int key = kbase + kt * 16 + quad * 4 + r; float x = sc[qt][kt][r] * SL;
                    if (MODE == 0) x += cq[qt] - ckv[kt][r];
                    if (MODE >= 2) { const int dd = q - key; float bs = c31; if (near) { int di = dd < 0 ? 0 : (dd > 127 ? 127 : dd); const float tv = tb[w * 128 + di]; bs = dd < 128 ? tv : c31; } x += bs; }
                    bool valid = key <= q;
                    if (MODE == 2) valid = valid && (q - key < 512);
                    if (MODE == 3) valid = valid && bit;
                    x = valid ? x : -INFINITY; sc[qt][kt][r] = x; mx = fmaxf(mx, x); }
            mx = fmaxf(mx, __shfl_xor(mx, 16)); mx = fmaxf(mx, __shfl_xor(mx, 32));
            const float mn = fmaxf(m[qt], mx), ms = (mn == -INFINITY) ? 0.f : mn;
            const float alpha = __builtin_amdgcn_exp2f(m[qt] - ms); m[qt] = mn;
            float rsum = 0.f;
#pragma unroll
            for (int kt = 0; kt < 4; ++kt) { float e0 = __builtin_amdgcn_exp2f(sc[qt][kt][0] - ms), e1 = __builtin_amdgcn_exp2f(sc[qt][kt][1] - ms), e2 = __builtin_amdgcn_exp2f(sc[qt][kt][2] - ms), e3 = __builtin_amdgcn_exp2f(sc[qt][kt][3] - ms);
                rsum += (e0 + e1) + (e2 + e3); pb[qt][kt][0] = pk2(e0, e1); pb[qt][kt][1] = pk2(e2, e3); }
            l[qt] = l[qt] * alpha + rsum;
#pragma unroll
            for (int d = 0; d < 4; ++d) o[qt][d] *= alpha;
        }
        pv_tile(Vs, pb, o, lane);
    }
#undef FL_LOAD
#undef FL_STORE
#pragma unroll
    for (int qt = 0; qt < 2; ++qt) { float lt = l[qt]; lt += __shfl_xor(lt, 16); lt += __shfl_xor(lt, 32); linv[qt] = 1.0f / fmaxf(lt, 1e-30f); }
}

template <int MODE>
__device__ __forceinline__ void flash_item(const AttnP& p, int item, char* smem) {
    const int lane = threadIdx.x & 63, w = threadIdx.x >> 6, l15 = lane & 15, quad = lane >> 4;
    FCtx c; const int nqt = S / 128; const int qt_ = nqt - 1 - item / (NB * 8), bh = item % (NB * 8);
    c.b = bh >> 3; c.hq = bh & 7; c.hkv = c.hq; c.qb_lo = qt_ * 128; c.qb_hi = c.qb_lo + 127; c.qw0 = c.qb_lo + w * 32;
    const unsigned mw[2][4] = {{0, 0, 0, 0}, {0, 0, 0, 0}}; f32x4 o[2][4]; float linv[2];
    flash_core<MODE>(p, c, smem, mw, o, linv);
#pragma unroll
    for (int qt = 0; qt < 2; ++qt) { const size_t row = (size_t)c.b * S + c.qw0 + qt * 16 + l15;
#pragma unroll
        for (int d = 0; d < 4; ++d) { const f32x4 v = o[qt][d] * linv[qt]; *(uint2*)(p.out + row * p.ldo + c.hq * 64 + d * 16 + quad * 4) = make_uint2(pk2(v[0], v[1]), pk2(v[2], v[3])); } }
}
template <int MODE>
__global__ void __launch_bounds__(256) k_flash(AttnP p) {
    __shared__ __attribute__((aligned(16))) char smem[FL_SMEM];
    flash_item<MODE>(p, blockIdx.x, smem);
}

__device__ __forceinline__ void cmp_core(const AttnP& p, const FCtx& c, char* smem, f32x4 (&o)[2][4], unsigned (&mw)[2][4]) {
    constexpr int KST = 72, VST = 72;
    bf16* Ks = (bf16*)smem; bf16* Vs = Ks + 64 * 104; float* cks = (float*)(Vs + 64 * VST); float* tb = cks + 64; float* imp = tb + 512; unsigned* selw = (unsigned*)(imp + 32 * IMPS);
    const int tid = threadIdx.x, lane = tid & 63, w = tid >> 6, l15 = lane & 15, quad = lane >> 4;
    const int hq = c.hq, qw0 = c.qw0, bg = c.b * 2 + c.hkv;
    const size_t rowb = (size_t)c.b * S;
    const int nk = qw0 / 16 + 1, ntile = (nk + 63) >> 6;
    const float SL = 0.125f * LOG2E; const float c31 = p.relb[31 * 8 + hq] * LOG2E;
    for (int i = tid; i < 32 * IMPS; i += 256) imp[i] = 0.f;
    bf16x8 qf[2][2];
#pragma unroll
    for (int qt = 0; qt < 2; ++qt)
#pragma unroll
        for (int ks = 0; ks < 2; ++ks) qf[qt][ks] = *(const bf16x8*)(p.q + (rowb + qw0 + qt * 16 + l15) * p.ldq + hq * 64 + ks * 32 + quad * 8);
    const bf16* kb = p.kcb + (size_t)bg * 512 * 64; const bf16* vb = p.vcb + (size_t)bg * 512 * 64;
#define CM_STAGE(tile_) do { __syncthreads(); \
        _Pragma("unroll") for (int i = 0; i < 2; ++i) { const int cc = tid + i * 256, key = cc >> 3, kc = cc & 7; \
            *(u32x4*)(Ks + key * KST + kc * 8) = *(const u32x4*)(kb + (size_t)((tile_) * 64 + key) * 64 + kc * 8); \
            *(u32x4*)(Vs + key * VST + kc * 8) = *(const u32x4*)(vb + (size_t)((tile_) * 64 + key) * 64 + kc * 8); } \
        __syncthreads(); } while (0)
#define CM_SCORE(tile_) do { qk_tile<2, KST>(Ks, qf, sc, l15, quad); \
        _Pragma("unroll") for (int qt = 0; qt < 2; ++qt) { const int q = qw0 + qt * 16 + l15; \
            _Pragma("unroll") for (int kt = 0; kt < 4; ++kt) _Pragma("unroll") for (int r = 0; r < 4; ++r) { const int ci = (tile_) * 64 + kt * 16 + quad * 4 + r; const int dd = q - (16 * ci + 31); \
                const int di = dd < 0 ? 0 : (dd > 127 ? 127 : dd); const float tv = tb[w * 128 + di]; const float bs = dd < 128 ? tv : c31; \
                sc[qt][kt][r] = (dd >= 0) ? sc[qt][kt][r] * SL + bs : -INFINITY; } } } while (0)
    float m[2] = {-INFINITY, -INFINITY}, l[2] = {0.f, 0.f};
    for (int tile = 0; tile < ntile; ++tile) {
        CM_STAGE(tile);
        f32x4 sc[2][4]; CM_SCORE(tile);
#pragma unroll
        for (int qt = 0; qt < 2; ++qt) { float mx = -INFINITY;
#pragma unroll
            for (int kt = 0; kt < 4; ++kt) mx = fmaxf(fmaxf(mx, fmaxf(sc[qt][kt][0], sc[qt][kt][1])), fmaxf(sc[qt][kt][2], sc[qt][kt][3]));
            mx = fmaxf(mx, __shfl_xor(mx, 16)); mx = fmaxf(mx, __shfl_xor(mx, 32));
            const float mn = fmaxf(m[qt], mx), ms = (mn == -INFINITY) ? 0.f : mn; const float alpha = __builtin_amdgcn_exp2f(m[qt] - ms); m[qt] = mn; float rsum = 0.f;
#pragma unroll
            for (int kt = 0; kt < 4; ++kt)
#pragma unroll
                for (int r = 0; r < 4; ++r) rsum += __builtin_amdgcn_exp2f(sc[qt][kt][r] - ms);
            l[qt] = l[qt] * alpha + rsum; }
    }
    float ms2[2], il[2];
#pragma unroll
    for (int qt = 0; qt < 2; ++qt) { float lt = l[qt]; lt += __shfl_xor(lt, 16); lt += __shfl_xor(lt, 32); il[qt] = 1.0f / fmaxf(lt, 1e-30f); ms2[qt] = (m[qt] == -INFINITY) ? 0.f : m[qt]; }
#pragma unroll
    for (int qt = 0; qt < 2; ++qt)
#pragma unroll
        for (int d = 0; d < 4; ++d) o[qt][d] = (f32x4){0.f, 0.f, 0.f, 0.f};
    for (int tile = 0; tile < ntile; ++tile) {
        CM_STAGE(tile);
        f32x4 sc[2][4]; CM_SCORE(tile);
        unsigned pb[2][4][2];
#pragma unroll
        for (int qt = 0; qt < 2; ++qt) { float* irow = imp + (qt * 16 + l15) * IMPS;
#pragma unroll
            for (int kt = 0; kt < 4; ++kt) { const float e0 = __builtin_amdgcn_exp2f(sc[qt][kt][0] - ms2[qt]) * il[qt], e1 = __builtin_amdgcn_exp2f(sc[qt][kt][1] - ms2[qt]) * il[qt],
                                                   e2 = __builtin_amdgcn_exp2f(sc[qt][kt][2] - ms2[qt]) * il[qt], e3 = __builtin_amdgcn_exp2f(sc[qt][kt][3] - ms2[qt]) * il[qt];
                pb[qt][kt][0] = pk2(e0, e1); pb[qt][kt][1] = pk2(e2, e3);
                const int j = tile * 16 + kt * 4 + quad; atomicAdd(irow + j, (e0 + e1) + (e2 + e3)); if (j + 1 < 128) atomicAdd(irow + j + 1, e3); } }
        pv_tile(Vs, pb, o, lane);
    }
#undef CM_STAGE
#undef CM_SCORE
    __syncthreads();
    {
        const int qy = tid >> 3, sub = tid & 7, cur = c.qb_lo >> 6;
        unsigned m0 = 1u, m1 = 0u, m2 = 0u, m3 = 0u;
#define SETBIT(j_) do { const int jj_ = (j_); const unsigned bb_ = 1u << (jj_ & 31); const int wi_ = jj_ >> 5; m0 |= wi_ == 0 ? bb_ : 0u; m1 |= wi_ == 1 ? bb_ : 0u; m2 |= wi_ == 2 ? bb_ : 0u; m3 |= wi_ == 3 ? bb_ : 0u; } while (0)
        if (cur <= 15) { m0 = (cur == 31) ? 0xffffffffu : ((1u << (cur + 1)) - 1u); }
        else {
            SETBIT(cur); SETBIT(cur - 1);
            float v[16];
#pragma unroll
            for (int i = 0; i < 16; ++i) { const int j = sub + 8 * i; v[i] = (j >= 1 && j <= cur - 2) ? imp[qy * IMPS + j] : -INFINITY; }
            for (int it = 0; it < 13; ++it) { float bv = -INFINITY; int bj = 1 << 20;
#pragma unroll
                for (int i = 0; i < 16; ++i) { if (v[i] > bv) { bv = v[i]; bj = sub + 8 * i; } }
#pragma unroll
                for (int off = 1; off < 8; off <<= 1) { const float ov = __shfl_xor(bv, off); const int oj = __shfl_xor(bj, off); if (ov > bv || (ov == bv && oj < bj)) { bv = ov; bj = oj; } }
                SETBIT(bj);
#pragma unroll
                for (int i = 0; i < 16; ++i) v[i] = (sub + 8 * i == bj) ? -INFINITY : v[i]; }
        }
#undef SETBIT
        if (sub == 0) { selw[qy * 4 + 0] = m0; selw[qy * 4 + 1] = m1; selw[qy * 4 + 2] = m2; selw[qy * 4 + 3] = m3; }
    }
    __syncthreads();
#pragma unroll
    for (int qt = 0; qt < 2; ++qt)
#pragma unroll
        for (int k = 0; k < 4; ++k) mw[qt][k] = selw[(qt * 16 + l15) * 4 + k];
}

__device__ __forceinline__ void nsa_item(const AttnP& p, int item, char* smem) {
    const int tid = threadIdx.x, lane = tid & 63, w = tid >> 6, l15 = lane & 15, quad = lane >> 4;
    FCtx c; const int nqt = S / 32; const int qt_ = nqt - 1 - item / (NB * 2), bg = item % (NB * 2);
    c.b = bg >> 1; c.hkv = bg & 1; c.hq = c.hkv * 4 + w; c.qb_lo = qt_ * 32; c.qb_hi = c.qb_lo + 31; c.qw0 = c.qb_lo;
    float* tb = (float*)(smem + 64 * 104 * 2 + 64 * 72 * 2 + 256);
    __syncthreads();
    tb[w * 128 + lane] = p.relb[p.bkt[lane] * 8 + c.hq] * LOG2E; tb[w * 128 + 64 + lane] = p.relb[p.bkt[64 + lane] * 8 + c.hq] * LOG2E;
    float gate[2][3];
#pragma unroll
    for (int qt = 0; qt < 2; ++qt) { const size_t row = (size_t)c.b * S + c.qw0 + qt * 16 + l15;
#pragma unroll
        for (int j = 0; j < 3; ++j) gate[qt][j] = sigmoidf_(bf2f(p.gl[row * LDW1 + C_GL + c.hq * 3 + j]) + p.bgate[c.hq * 3 + j]); }
    unsigned mw[2][4]; f32x4 y[2][4], o[2][4]; float linv[2];
    cmp_core(p, c, smem, o, mw);
#pragma unroll
    for (int qt = 0; qt < 2; ++qt)
#pragma unroll
        for (int d = 0; d < 4; ++d) y[qt][d] = o[qt][d] * gate[qt][0];
    flash_core<3>(p, c, smem, mw, o, linv);
#pragma unroll
    for (int qt = 0; qt < 2; ++qt)
#pragma unroll
        for (int d = 0; d < 4; ++d) y[qt][d] += o[qt][d] * (gate[qt][1] * linv[qt]);
    flash_core<2>(p, c, smem, mw, o, linv);
#pragma unroll
    for (int qt = 0; qt < 2; ++qt) { const size_t row = (size_t)c.b * S + c.qw0 + qt * 16 + l15;
#pragma unroll
        for (int d = 0; d < 4; ++d) { const f32x4 v = y[qt][d] + o[qt][d] * (gate[qt][2] * linv[qt]); *(uint2*)(p.out + row * p.ldo + c.hq * 64 + d * 16 + quad * 4) = make_uint2(pk2(v[0], v[1]), pk2(v[2], v[3])); } }
}
__global__ void __launch_bounds__(256) k_nsa(AttnP p) {
    __shared__ __attribute__((aligned(16))) char smem[FL_SMEM];
    nsa_item(p, blockIdx.x, smem);
}

struct S5P { const float* u0; const float *lre, *lim, *ldt, *bre, *bim, *cre, *cim, *dsk; float* E; bf16* hg; };
constexpr int S5_L = 128, S5_NC = S / S5_L, S5_XST = 136, S5_SMEM = 4 * 64 * S5_XST * 2;
template <bool PASSB>
__device__ __forceinline__ void s5_item(const S5P& p, int item, char* smem) {
    const int tid = threadIdx.x, lane = tid & 63, w = tid >> 6, l15 = lane & 15, quad = lane >> 4;
    const int witem = item * 4 + w, bg = witem / S5_NC, chunk = witem % S5_NC, b = bg >> 5, g = bg & 31, pp = lane;
    bf16* Xs = (bf16*)smem + w * 64 * S5_XST;
    const float lr = p.lre[g * 64 + pp], li = p.lim[g * 64 + pp], dt = __expf(p.ldt[g]);
    const float mag = __expf(lr * dt), ar = mag * cosf(li * dt), ai = mag * sinf(li * dt);
    const float den = lr * lr + li * li, nr = ar - 1.0f, ni = ai;
    const float fr = (nr * lr + ni * li) / den, fi = (ni * lr - nr * li) / den;
    float bbr[16], bbi[16];
#pragma unroll
    for (int cc = 0; cc < 16; ++cc) { const float br = p.bre[(g * 64 + pp) * 16 + cc], bi = p.bim[(g * 64 + pp) * 16 + cc]; bbr[cc] = fr * br - fi * bi; bbi[cc] = fr * bi + fi * br; }
    float sr = 0.f, si = 0.f;
    bf16x8 cf[4];
    if (PASSB) {
        float pr = ar, pi = ai;
#pragma unroll
        for (int i = 0; i < 7; ++i) { const float t = pr * pr - pi * pi; pi = 2.f * pr * pi; pr = t; }
        for (int cpr = 0; cpr < chunk; ++cpr) { const float2 e = *(const float2*)(p.E + ((size_t)(bg * S5_NC + cpr) * 64 + pp) * 2); const float t = pr * sr - pi * si + e.x; si = pr * si + pi * sr + e.y; sr = t; }
#pragma unroll
        for (int ks = 0; ks < 4; ++ks)
#pragma unroll
            for (int j = 0; j < 8; ++j) { const int k = ks * 32 + quad * 8 + j, st = k >> 1; const float v = (k & 1) ? -p.cim[(g * 16 + l15) * 64 + st] : p.cre[(g * 16 + l15) * 64 + st]; cf[ks][j] = (short)f2bf(v); }
    }
    const int t0 = chunk * S5_L;
    for (int sub = 0; sub < S5_L / 64; ++sub) {
        for (int tt = 0; tt < 64; ++tt) {
            const float* up = p.u0 + (size_t)(b * S + t0 + sub * 64 + tt) * 512 + g * 16; float br_ = 0.f, bi_ = 0.f;
#pragma unroll
            for (int cc = 0; cc < 16; ++cc) { const float uv = up[cc]; br_ += bbr[cc] * uv; bi_ += bbi[cc] * uv; }
            const float nsr = ar * sr - ai * si + br_, nsi = ar * si + ai * sr + bi_; sr = nsr; si = nsi;
            if (PASSB) *(unsigned*)(Xs + tt * S5_XST + 2 * pp) = pk2(sr, si);
        }
        if (PASSB) {
            __syncthreads();
#pragma unroll
            for (int tile = 0; tile < 4; ++tile) { f32x4 acc = {0.f, 0.f, 0.f, 0.f};
#pragma unroll
                for (int ks = 0; ks < 4; ++ks) { const bf16x8 xf = *(const bf16x8*)(Xs + (tile * 16 + l15) * S5_XST + ks * 32 + quad * 8); acc = __builtin_amdgcn_mfma_f32_16x16x32_bf16(cf[ks], xf, acc, 0, 0, 0); }
                const size_t row = (size_t)b * S + t0 + sub * 64 + tile * 16 + l15; const int ch = g * 16 + quad * 4;
                const f32x4 uv = *(const f32x4*)(p.u0 + row * 512 + ch); const f32x4 dv = *(const f32x4*)(p.dsk + ch);
                const f32x4 yv = acc + dv * uv;
                *(uint2*)(p.hg + row * 512 + ch) = make_uint2(pk2(gelu_tanh(yv[0]), gelu_tanh(yv[1])), pk2(gelu_tanh(yv[2]), gelu_tanh(yv[3]))); }
            __syncthreads();
        }
    }
    if (!PASSB) *(float2*)(p.E + ((size_t)(bg * S5_NC + chunk) * 64 + pp) * 2) = make_float2(sr, si);
}
template <bool PASSB>
__global__ void __launch_bounds__(256) k_s5(S5P p) {
    __shared__ __attribute__((aligned(16))) char smem[S5_SMEM];
    s5_item<PASSB>(p, blockIdx.x, smem);
}

__global__ void __launch_bounds__(64) k_nsa_cmp_naive(const bf16* w1o, const float* kc, const float* vc, const float* relb, const int* bkt, const float* bgate, float* ynsa, float* imp) {
    const int blk = blockIdx.x; const int tb = blk & (S / 64 - 1), bg = blk / (S / 64), b = bg >> 1, g = bg & 1;
    const int t0 = tb * 64, t = t0 + threadIdx.x; const size_t row = (size_t)b * S + t;
    float* ir = imp + (row * 2 + g) * 128;
    for (int j = 0; j < 128; ++j) ir[j] = 0.f;
    const int nk_max = (t0 + 63 >= 31) ? ((t0 + 63 - 31) / 16 + 1) : 0;
    const int nk = (t >= 31) ? ((t - 31) / 16 + 1) : 0;
    const float* kb = kc + (size_t)bg * 512 * 64; const float* vb = vc + (size_t)bg * 512 * 64;
    for (int r = 0; r < 4; ++r) {
        const int h = g * 4 + r; float qv[64], o[64];
#pragma unroll
        for (int d = 0; d < 64; ++d) { qv[d] = bf2f(w1o[row * LDW1 + C_QN + h * 64 + d]); o[d] = 0.f; }
        float m = -1e30f, l = 0.f;
        for (int i = 0; i < nk_max; ++i) { float s = 0.f;
#pragma unroll
            for (int d = 0; d < 64; ++d) s += qv[d] * kb[i * 64 + d];
            s = s * 0.125f + t5b(relb, bkt, h, (t - (16 * i + 31)) > 0 ? (t - (16 * i + 31)) : 0);
            if (i < nk) { float mn = fmaxf(m, s), corr = __expf(m - mn), pe = __expf(s - mn); l = l * corr + pe; m = mn;
#pragma unroll
                for (int d = 0; d < 64; ++d) o[d] = o[d] * corr + pe * vb[i * 64 + d]; } }
        const float inv = 1.0f / fmaxf(l, 1e-30f);
        const float gate = sigmoidf_(bf2f(w1o[row * LDW1 + C_GL + h * 3 + 0]) + bgate[h * 3 + 0]);
#pragma unroll
        for (int d = 0; d < 64; ++d) ynsa[row * 512 + h * 64 + d] = gate * o[d] * inv;
        for (int i = 0; i < nk_max; ++i) { float s = 0.f;
#pragma unroll
            for (int d = 0; d < 64; ++d) s += qv[d] * kb[i * 64 + d];
            s = s * 0.125f + t5b(relb, bkt, h, (t - (16 * i + 31)) > 0 ? (t - (16 * i + 31)) : 0);
            if (i < nk) { float pr = __expf(s - m) * inv; ir[i >> 2] += pr; if ((i & 3) == 3 && (i >> 2) + 1 < 128) ir[(i >> 2) + 1] += pr; } }
    }
}
__global__ void k_topk_naive(const float* imp, unsigned* selm) {
    int idx = blockIdx.x * blockDim.x + threadIdx.x; if (idx >= T * 2) return;
    int row = idx >> 1; int t = row & (S - 1); int cur = t >> 6; const float* ir = imp + (size_t)idx * 128;
    unsigned long long lo = 1ull, hi = 0ull;
    if (cur < 64) lo |= 1ull << cur; else hi |= 1ull << (cur - 64);
    if (cur >= 1) { if (cur - 1 < 64) lo |= 1ull << (cur - 1); else hi |= 1ull << (cur - 1 - 64); }
    int nf = __popcll(lo) + __popcll(hi); int rem = 16 - nf;
    for (int it = 0; it < rem; ++it) { int best = -1; float bv = -1e30f;
        for (int j = 1; j <= cur - 2; ++j) { bool taken = j < 64 ? ((lo >> j) & 1ull) : ((hi >> (j - 64)) & 1ull); float v = ir[j]; if (!taken && v > bv) { bv = v; best = j; } }
        if (best < 0) break; if (best < 64) lo |= 1ull << best; else hi |= 1ull << (best - 64); }
    unsigned* sm = selm + (size_t)idx * 4; sm[0] = (unsigned)lo; sm[1] = (unsigned)(lo >> 32); sm[2] = (unsigned)hi; sm[3] = (unsigned)(hi >> 32);
}
__global__ void k_nsa_fin(const float* ynsa, bf16* ycat) {
    for (long i = (long)blockIdx.x * blockDim.x + threadIdx.x; i < (long)T * 512; i += (long)gridDim.x * blockDim.x) { long r = i >> 9; int c = (int)(i & 511); ycat[r * D + 512 + c] = f2bf(ynsa[i]); }
}

static inline size_t al(size_t x) { return (x + 255) & ~(size_t)255; }

#ifndef NAIVE_S5
#define NAIVE_S5 0
#endif
#ifndef NAIVE_NSA
#define NAIVE_NSA 0
#endif
#ifndef NAIVE_ATTN
#define NAIVE_ATTN 0
#endif
#ifndef NAIVE_GEMM
#define NAIVE_GEMM 0
#endif
template <class Epi, bool DUAL> static void run_gemm(const GemmP& g, const Epi& e, hipStream_t st) {
    if (NAIVE_GEMM) gemm_naive<Epi, DUAL><<<2048, 256, 0, st>>>(g, e);
    else gemm_mfma<Epi, DUAL><<<1024, 256, 0, st>>>(g, e);
}

extern "C" void kernel_launch(void* const* d_in, const int* in_sizes, int n_in, void* d_out, int out_size, void* d_ws, size_t ws_size, hipStream_t stream) {
    const float* const* in = (const float* const*)d_in;
    float* h = (float*)d_out;
    char* w = (char*)d_ws; size_t off = 0;
    WS ws{};
    ws.hb = (bf16*)(w + off); off += al((size_t)T * D * 2);
    ws.rs = (float*)(w + off); off += al((size_t)T * 4);
    ws.rsq = (float*)(w + off); off += al((size_t)T * 4);
    ws.rskv = (float*)(w + off); off += al((size_t)T * 4);
    ws.flog = (float*)(w + off); off += al((size_t)T * 8 * 4);
    ws.cum = (float*)(w + off); off += al((size_t)T * 8 * 4);
    ws.selm = (unsigned*)(w + off); off += al((size_t)T * 2 * 4 * 4);
    ws.kcmp = (float*)(w + off); off += al((size_t)4 * 512 * 64 * 4);
    ws.vcmp = (float*)(w + off); off += al((size_t)4 * 512 * 64 * 4);
    ws.chid = (bf16*)(w + off); off += al((size_t)2 * 2048 * 128 * 2);
    ws.kcb = (bf16*)(w + off); off += al((size_t)4 * 512 * 64 * 2);
    ws.vcb = (bf16*)(w + off); off += al((size_t)4 * 512 * 64 * 2);
    ws.s5e = (float*)(w + off); off += al((size_t)64 * S5_NC * 64 * 2 * 4);
    ws.cb1 = (float*)(w + off); off += al(256 * 4);
    ws.bkt = (int*)(w + off); off += al(128 * 4);
    ws.ycat = (bf16*)(w + off); off += al((size_t)T * D * 2);
    size_t r0 = off;
    ws.hid = (bf16*)(w + r0);
    ws.u0 = (float*)(w + r0); ws.qkv0 = (bf16*)(w + r0 + al((size_t)T * 512 * 4));
    ws.w1o = (bf16*)(w + r0); ws.qmla = (bf16*)(w + r0 + al((size_t)T * LDW1 * 2));
    off = r0 + al((size_t)T * FF * 2);
    size_t r2 = off;
    ws.hg = (bf16*)(w + r2);
    ws.kvmla = (bf16*)(w + r2); ws.ynsa = (float*)(w + r2 + al((size_t)T * 1024 * 2)); ws.imp = (float*)(w + r2 + al((size_t)T * 1024 * 2) + al((size_t)T * 512 * 4));

    k_misc<<<1, 256, 0, stream>>>(in[34], in[35], in[36], in[38], ws.cb1, ws.bkt);
    k_init<<<2048, 256, 0, stream>>>(in[0], h, ws.hb);

    auto ffn = [&](int base) {
        k_rownorm_f32<<<1024, 256, 0, stream>>>(h, D, D, ws.rs, T);
        GemmP g1{}; g1.A = ws.hb; g1.lda = D; g1.W = in[base + 1]; g1.W2 = in[base + 2]; g1.ldw = FF; g1.bmode = 1; g1.gain = in[base]; g1.M = T; g1.N = 2 * FF; g1.K = D;
        run_gemm<EpiFFN1, true>(g1, EpiFFN1{ws.hid, ws.rs}, stream);
        GemmP g2{}; g2.A = ws.hid; g2.lda = FF; g2.W = in[base + 3]; g2.ldw = D; g2.M = T; g2.N = D; g2.K = FF;
        run_gemm<EpiRes, false>(g2, EpiRes{h, h, ws.hb, 0.5f}, stream);
    };

    ffn(2);
    k_rownorm_f32<<<1024, 256, 0, stream>>>(h, D, D, ws.rs, T);
    { GemmP g{}; g.A = ws.hb; g.lda = D; g.W = in[7]; g.ldw = EVEN_IN; g.gain = in[6]; g.M = T; g.N = EVEN_IN; g.K = D;
      run_gemm<EpiWin0, false>(g, EpiWin0{ws.u0, ws.qkv0, ws.flog, ws.rs}, stream); }
    k_foxcum<<<16, 64, 0, stream>>>(ws.flog, in[18], ws.cum);
    if (NAIVE_S5) k_s5_naive<<<64, 64, 0, stream>>>(ws.u0, in[8], in[9], in[10], in[11], in[12], in[13], in[14], in[15], ws.hg);
    else { S5P sp{ws.u0, in[8], in[9], in[10], in[11], in[12], in[13], in[14], in[15], ws.s5e, ws.hg};
        k_s5<false><<<64 * S5_NC / 4, 256, 0, stream>>>(sp); k_s5<true><<<64 * S5_NC / 4, 256, 0, stream>>>(sp); }
    { GemmP g{}; g.A = ws.hg; g.lda = 512; g.W = in[16]; g.ldw = 512; g.M = T; g.N = 512; g.K = 512;
      run_gemm<EpiGlu, false>(g, EpiGlu{ws.hg, in[17], ws.ycat}, stream); }
    { AttnP a{}; a.q = ws.qkv0; a.ldq = 1536; a.k = ws.qkv0 + 512; a.ldk = 1536; a.v = ws.qkv0 + 1024; a.ldv = 1536; a.cum = ws.cum; a.out = ws.ycat + 512; a.ldo = D;
      if (NAIVE_ATTN) k_attn_naive<0><<<NB * 8 * (S / 64), 64, 0, stream>>>(a); else k_flash<0><<<1024, 256, 0, stream>>>(a); }
    { GemmP g{}; g.A = ws.ycat; g.lda = D; g.W = in[19]; g.ldw = D; g.M = T; g.N = D; g.K = D;
      run_gemm<EpiRes, false>(g, EpiRes{h, h, ws.hb, 1.0f}, stream); }
    ffn(20);
    ffn(24);
    k_rownorm_f32<<<1024, 256, 0, stream>>>(h, D, D, ws.rs, T);
    { GemmP g{}; g.A = ws.hb; g.lda = D; g.W = in[29]; g.ldw = ODD_IN; g.bmode = 3; g.gain = in[28]; g.M = T; g.N = ODD_IN; g.K = D;
      run_gemm<EpiWin1, false>(g, EpiWin1{ws.w1o, ws.rs}, stream); }
    k_rownorm_bf<<<1024, 256, 0, stream>>>(ws.w1o + C_CQ, LDW1, 384, ws.rsq, T);
    k_rownorm_bf<<<1024, 256, 0, stream>>>(ws.w1o + C_CKV, LDW1, 256, ws.rskv, T);
    { GemmP g{}; g.A = ws.w1o + C_CQ; g.lda = LDW1; g.W = in[31]; g.ldw = 768; g.bmode = 2; g.gain = in[30]; g.M = T; g.N = 768; g.K = 384;
      run_gemm<EpiUq, false>(g, EpiUq{ws.qmla, ws.rsq}, stream); }
    { GemmP g{}; g.A = ws.w1o + C_CKV; g.lda = LDW1; g.W = in[33]; g.ldw = 1024; g.gain = in[32]; g.M = T; g.N = 1024; g.K = 256;
      run_gemm<EpiUkv, false>(g, EpiUkv{ws.kvmla, ws.rskv}, stream); }
    for (int kv = 0; kv < 2; ++kv) {
        GemmP g{}; g.A = ws.w1o; g.lda = LDW1; g.amode = 1; g.acoff = kv ? C_VC : C_KC; g.W = in[kv ? 38 : 36]; g.ldw = 128; g.M = 2048; g.N = 128; g.K = 2048;
        run_gemm<EpiCmp1, false>(g, EpiCmp1{ws.chid + (size_t)kv * 2048 * 128, ws.cb1 + kv * 128}, stream);
        GemmP g2{}; g2.A = ws.chid + (size_t)kv * 2048 * 128; g2.lda = 128; g2.W = in[kv ? 39 : 37]; g2.ldw = 64; g2.M = 2048; g2.N = 64; g2.K = 128;
        run_gemm<EpiCmp2, false>(g2, EpiCmp2{kv ? ws.vcmp : ws.kcmp, kv ? ws.vcb : ws.kcb}, stream);
    }
    { AttnP a{}; a.q = ws.qmla; a.ldq = 768; a.k = ws.kvmla; a.ldk = 1024; a.v = ws.kvmla; a.ldv = 1024; a.k2 = ws.w1o; a.out = ws.ycat; a.ldo = D;
      if (NAIVE_ATTN) k_attn_naive<1><<<NB * 8 * (S / 64), 64, 0, stream>>>(a); else k_flash<1><<<1024, 256, 0, stream>>>(a); }
    if (NAIVE_NSA) {
    k_nsa_cmp_naive<<<NB * 2 * (S / 64), 64, 0, stream>>>(ws.w1o, ws.kcmp, ws.vcmp, in[1], ws.bkt, in[40], ws.ynsa, ws.imp);
    k_topk_naive<<<(T * 2 + 255) / 256, 256, 0, stream>>>(ws.imp, ws.selm);
    { AttnP a{}; a.q = ws.w1o + C_QN; a.ldq = LDW1; a.k = ws.w1o + C_KS; a.ldk = LDW1; a.v = ws.w1o + C_VS; a.ldv = LDW1; a.relb = in[1]; a.bkt = ws.bkt; a.selm = ws.selm; a.gl = ws.w1o; a.bgate = in[40]; a.ynsa = ws.ynsa;
      k_attn_naive<3><<<NB * 8 * (S / 64), 64, 0, stream>>>(a);
      a.k = ws.w1o + C_KW; a.v = ws.w1o + C_VW;
      k_attn_naive<2><<<NB * 8 * (S / 64), 64, 0, stream>>>(a); }
    k_nsa_fin<<<2048, 256, 0, stream>>>(ws.ynsa, ws.ycat);
    } else {
        AttnP a{}; a.q = ws.w1o + C_QN; a.ldq = LDW1; a.k = ws.w1o + C_KS; a.ldk = LDW1; a.v = ws.w1o + C_VS; a.ldv = LDW1; a.kw = ws.w1o + C_KW; a.vw = ws.w1o + C_VW;
        a.relb = in[1]; a.bkt = ws.bkt; a.gl = ws.w1o; a.bgate = in[40]; a.kcb = ws.kcb; a.vcb = ws.vcb; a.out = ws.ycat + 512; a.ldo = D;
        k_nsa<<<1024, 256, 0, stream>>>(a);
    }
    { GemmP g{}; g.A = ws.ycat; g.lda = D; g.W = in[41]; g.ldw = D; g.M = T; g.N = D; g.K = D;
      run_gemm<EpiRes, false>(g, EpiRes{h, h, ws.hb, 1.0f}, stream); }
    ffn(42);
    k_final<<<1024, 256, 0, stream>>>(h, in[46], h);
}
```

```cpp
#include <hip/hip_runtime.h>
#include <hip/hip_cooperative_groups.h>
#include <cstdio>
#include <stdint.h>
namespace cg = cooperative_groups;

typedef unsigned short bf16;
typedef float f32x4 __attribute__((ext_vector_type(4)));
typedef short bf16x8 __attribute__((ext_vector_type(8)));
typedef unsigned u32x4 __attribute__((ext_vector_type(4)));
typedef unsigned u32x2 __attribute__((ext_vector_type(2)));
typedef short s16x4 __attribute__((ext_vector_type(4)));
#define LDS_AS __attribute__((address_space(3)))

constexpr int NB = 2, S = 8192, T = NB * S, D = 1024, FF = 2816;
constexpr int EVEN_IN = 2056, ODD_IN = 1976, LDW1 = 1984;
constexpr int C_CQ = 0, C_CKV = 384, C_KR = 640, C_QN = 672, C_KC = 1184, C_VC = 1312, C_KS = 1440, C_VS = 1568, C_KW = 1696, C_VW = 1824, C_GL = 1952;
constexpr float LOG2E = 1.4426950408889634f;

typedef __bf16 nbf2 __attribute__((ext_vector_type(2)));
typedef float f32x2 __attribute__((ext_vector_type(2)));
__device__ __forceinline__ unsigned pk2(float a, float b) { const f32x2 v = {a, b}; return __builtin_bit_cast(unsigned, __builtin_convertvector(v, nbf2)); }
__device__ __forceinline__ bf16 f2bf(float f) { return (bf16)(pk2(f, 0.f) & 0xffffu); }
__device__ __forceinline__ float bf2f(bf16 h) { return __uint_as_float(((unsigned)h) << 16); }
__device__ __forceinline__ float sigmoidf_(float x) { return __builtin_amdgcn_rcpf(1.0f + __expf(-x)); }
__device__ __forceinline__ float gelu_tanh(float x) { float u = 0.7978845608028654f * (x + 0.044715f * x * x * x); return 0.5f * x * (1.0f + tanhf(u)); }
__device__ __forceinline__ float log_sigmoid(float x) { return fminf(x, 0.f) - __logf(1.0f + __expf(-fabsf(x))); }
__device__ __forceinline__ float xrow16_max(float x) {
    auto s_ = __builtin_amdgcn_permlane16_swap(__float_as_uint(x), __float_as_uint(x), false, false);
    x = fmaxf(__uint_as_float(s_[0]), __uint_as_float(s_[1]));
    auto t_ = __builtin_amdgcn_permlane32_swap(__float_as_uint(x), __float_as_uint(x), false, false);
    return fmaxf(__uint_as_float(t_[0]), __uint_as_float(t_[1]));
}
__device__ __forceinline__ float xrow16_sum(float x) {
    auto s_ = __builtin_amdgcn_permlane16_swap(__float_as_uint(x), __float_as_uint(x), false, false);
    x = __uint_as_float(s_[0]) + __uint_as_float(s_[1]);
    auto t_ = __builtin_amdgcn_permlane32_swap(__float_as_uint(x), __float_as_uint(x), false, false);
    return __uint_as_float(t_[0]) + __uint_as_float(t_[1]);
}
__device__ __forceinline__ uint2 pk4(f32x4 v) { return make_uint2(pk2(v[0], v[1]), pk2(v[2], v[3])); }

namespace pg8 {
#define PG8_LAS __attribute__((address_space(3)))
typedef unsigned short bf16_t;
typedef short bf16x8 __attribute__((ext_vector_type(8)));
typedef float f32x4 __attribute__((ext_vector_type(4)));
typedef unsigned u32x4 __attribute__((ext_vector_type(4)));
constexpr int BM = 256, BK = 64, HALF = 128, HTB = HALF * BK * 2  , STAGE_BYTES = 8 * HTB, NXCD = 8, WGM = 8;

__host__ __device__ __forceinline__ int lds_byte(int r, int c) { const int st = (r >> 4) * 2 + (c >> 5), rr = r & 15, cc = c & 31, ob = rr * 64 + cc * 2; return st * 1024 + (ob ^ (((ob >> 9) & 1) << 5)); }
__host__ __device__ __forceinline__ void stage_rc(int b, int& R, int& C) { const int st = b / 1024, sb = b % 1024, swz = sb ^ (((sb >> 9) & 1) << 5); R = (st >> 1) * 16 + swz / 64; C = (st & 1) * 32 + (swz % 64) / 2; }
__host__ __device__ __forceinline__ int perm32(int rho) { const int n = rho >> 4, i = rho & 15; return 8 * (i >> 2) + 4 * n + (i & 3); }

struct Unit { int pm, pn; };
struct Gemm { const bf16_t* A; const bf16_t* Bt; int M, N, K, lda; };

struct StaticOrder {
    int nM, nN, nwg, G, c;
    __host__ __device__ void init(int M, int N, int G_, int c_) { nM = M / BM; nN = N / BM; nwg = nM * nN; G = G_; c = c_; }
    __host__ __device__ bool next(int i, Unit& u) const {
        const long L = (long)i * G + c; if (L >= nwg) return false;
        int wgid = (int)L; { const int q = nwg / NXCD, r = nwg % NXCD, xcd = wgid % NXCD, off = wgid / NXCD; wgid = (xcd < r ? xcd * (q + 1) : r * (q + 1) + (xcd - r) * q) + off; }
        const int nig = WGM * nN, gid = wgid / nig, fm = gid * WGM, gsz = (nM - fm) < WGM ? (nM - fm) : WGM;
        u.pm = fm + ((wgid % nig) % gsz); u.pn = (wgid % nig) / gsz; return true;
    }
    __device__ __forceinline__ void a_ready(const Unit&) const {}
    __device__ __forceinline__ void done(const Unit&) const {}
};
__device__ __forceinline__ unsigned cvt_pk_bf16(float lo, float hi) { unsigned r; asm volatile("v_cvt_pk_bf16_f32 %0, %1, %2" : "=v"(r) : "v"(lo), "v"(hi)); return r; }
template <class Epi, class Sched, bool ALIGN_EPI = false, bool SP2 = false>
__device__ __forceinline__ void gemm_phase(PG8_LAS unsigned char* lds, const Gemm g, const Sched& S, const Epi& E) {
    int tid_ = threadIdx.x; asm volatile("" : "+v"(tid_));
    const int tid = tid_, wid = __builtin_amdgcn_readfirstlane(tid >> 6), lane = tid & 63, wr = wid >> 2, wc = wid & 3, fr = lane & 15, fq = lane >> 4;
    const int K = g.K, nt = K / BK;
    unsigned voffA[2], voffB[2];
#pragma unroll
    for (int i = 0; i < 2; ++i) { int R, C; stage_rc(tid * 16 + i * 8192, R, C); const int Rb = Epi::PERM ? ((R & ~31) + perm32(R & 31)) : R;
        voffA[i] = (unsigned)(R * g.lda + C) * 2u; voffB[i] = (unsigned)(Rb * K + C) * 2u; }
    const size_t kstep = (size_t)(BK * 2);
    const size_t hstep = (size_t)HALF * K * 2;
    const size_t tstep = 2 * hstep;
    const size_t hstepA = (size_t)HALF * g.lda * 2, tstepA = 2 * hstepA;
    const unsigned ldsw = (unsigned)wid * 1024u;
    const int aoff = lds_byte(wr * 64 + fr, fq * 8), boff = lds_byte(wc * 32 + fr, fq * 8);
    PG8_LAS unsigned char* ldsb = lds + 4 * HTB + boff; asm volatile("" : "+v"(ldsb));
#define PG8_SA(b, h) (((b) * 2 + (h)) * HTB)
#define PG8_SB(b, h) ((4 + (b) * 2 + (h)) * HTB)
#define PG8_STAGE(bufoff, gbase, voff) do { _Pragma("unroll") for (int _i = 0; _i < 2; ++_i) \
        __builtin_amdgcn_global_load_lds((const unsigned*)((const char*)(gbase) + (voff)[_i]), (PG8_LAS unsigned*)(lds + (bufoff) + ldsw + _i * 8192), 16, 0, 0); } while (0)
#define PG8_LDA(dst, b, h) do { _Pragma("unroll") for (int m = 0; m < 4; ++m) _Pragma("unroll") for (int k = 0; k < 2; ++k) dst[m][k] = *(const PG8_LAS bf16x8*)(lds + PG8_SA(b, h) + aoff + m * 2048 + k * 1024); } while (0)
#define PG8_LDB(dst, b, h) do { _Pragma("unroll") for (int n = 0; n < 2; ++n) _Pragma("unroll") for (int k = 0; k < 2; ++k) dst[n][k] = *(const PG8_LAS bf16x8*)(ldsb + ((b) * 2 + (h)) * HTB + n * 2048 + k * 1024); } while (0)
#define PG8_MMA(ai, bj, At, Bt) do { __builtin_amdgcn_s_setprio(1); _Pragma("unroll") for (int m = 0; m < 4; ++m) _Pragma("unroll") for (int n = 0; n < 2; ++n) _Pragma("unroll") for (int k = 0; k < 2; ++k) \
        acc[ai][bj][m][n] = __builtin_amdgcn_mfma_f32_16x16x32_bf16(Bt[n][k], At[m][k], acc[ai][bj][m][n], 0, 0, 0); __builtin_amdgcn_s_setprio(0); } while (0)
#define PG8_WAIT_V(n) asm volatile("s_waitcnt vmcnt(" #n ")" ::: "memory")
#define PG8_WAIT_L(n) asm volatile("s_waitcnt lgkmcnt(" #n ")" ::: "memory")
#define PG8_BAR __builtin_amdgcn_s_barrier()
#define PG8_SCHED __builtin_amdgcn_sched_barrier(0)
    Unit cur, nxt; int ui = 0;
    if (!S.next(0, cur)) return;
    f32x4 acc[2][2][4][2];
#pragma unroll
    for (int a = 0; a < 2; ++a)
#pragma unroll
        for (int b = 0; b < 2; ++b)
#pragma unroll
            for (int m = 0; m < 4; ++m)
#pragma unroll
                for (int n = 0; n < 2; ++n) acc[a][b][m][n] = (f32x4){0.f, 0.f, 0.f, 0.f};
    bf16x8 At[4][2], B0[2][2], B1[2][2];
    const char* cA = (const char*)g.A + (size_t)cur.pm * tstepA; const char* cB = (const char*)g.Bt + (size_t)cur.pn * tstep;
    S.a_ready(cur);
    if constexpr (SP2) {
        PG8_STAGE(PG8_SB(0, 0), cB, voffB); PG8_STAGE(PG8_SB(0, 1), cB + hstep, voffB); PG8_STAGE(PG8_SA(0, 0), cA, voffA); PG8_STAGE(PG8_SA(0, 1), cA + hstepA, voffA);
        if (wr == 1) PG8_BAR;
        PG8_WAIT_V(2); PG8_BAR;
        PG8_STAGE(PG8_SB(1, 0), cB + kstep, voffB); PG8_STAGE(PG8_SA(1, 0), cA + kstep, voffA); PG8_STAGE(PG8_SB(1, 1), cB + hstep + kstep, voffB);
        PG8_WAIT_V(6); PG8_BAR;
    } else {
        PG8_STAGE(PG8_SB(0, 0), cB, voffB); PG8_STAGE(PG8_SA(0, 0), cA, voffA); PG8_STAGE(PG8_SB(0, 1), cB + hstep, voffB); PG8_STAGE(PG8_SA(0, 1), cA + hstepA, voffA);
        if (wr == 1) PG8_BAR;
        PG8_WAIT_V(4); PG8_BAR;
        PG8_STAGE(PG8_SB(1, 0), cB + kstep, voffB); PG8_STAGE(PG8_SA(1, 0), cA + kstep, voffA); PG8_STAGE(PG8_SB(1, 1), cB + hstep + kstep, voffB);
        PG8_WAIT_V(6); PG8_BAR;
    }
    for (;;) {
        const bool has_next = S.next(ui + 1, nxt);
        const char* nA = has_next ? (const char*)g.A + (size_t)nxt.pm * tstepA : cA; const char* nB = has_next ? (const char*)g.Bt + (size_t)nxt.pn * tstep : cB;
        for (int t = 0; t < nt; t += 2) {
            const bool last = (t == nt - 2);
            const char* a1 = cA + (size_t)(t + 1) * kstep;
            const char* a2 = last ? nA : cA + (size_t)(t + 2) * kstep; const char* b2 = last ? nB : cB + (size_t)(t + 2) * kstep;
            const char* a3 = a2 + kstep; const char* b3 = b2 + kstep;
            if (last && has_next) S.a_ready(nxt);
            if constexpr (Epi::RSDMA) {
                if (last) {
                    const char* rsrc = (const char*)(E.rs_src() + (size_t)cur.pm * 1024 + wid * 128);
                    const unsigned rvo = (unsigned)lane * 4u;
                    __builtin_amdgcn_global_load_lds((const unsigned*)(rsrc + rvo), (PG8_LAS unsigned*)(lds + STAGE_BYTES + wid * 512), 4, 0, 0);
                    __builtin_amdgcn_global_load_lds((const unsigned*)(rsrc + 256 + rvo), (PG8_LAS unsigned*)(lds + STAGE_BYTES + wid * 512 + 256), 4, 0, 0); } }
            if constexpr (SP2) {
            PG8_LDB(B0, 0, 0); PG8_LDB(B1, 0, 1); PG8_SCHED; PG8_LDA(At, 0, 0); PG8_STAGE(PG8_SA(1, 1), a1 + hstepA, voffA);
            PG8_WAIT_V(8); PG8_WAIT_L(0); PG8_BAR; PG8_MMA(0, 0, At, B0); PG8_MMA(0, 1, At, B1); PG8_BAR; PG8_SCHED;
            PG8_LDA(At, 0, 1); PG8_STAGE(PG8_SB(0, 0), b2, voffB); PG8_STAGE(PG8_SB(0, 1), b2 + hstep, voffB); PG8_STAGE(PG8_SA(0, 0), a2, voffA);
            PG8_WAIT_V(8); PG8_WAIT_L(0); PG8_BAR; PG8_MMA(1, 0, At, B0); PG8_MMA(1, 1, At, B1); PG8_BAR; PG8_SCHED;
            PG8_LDB(B0, 1, 0); PG8_LDB(B1, 1, 1); PG8_SCHED; PG8_LDA(At, 1, 0); PG8_STAGE(PG8_SA(0, 1), a2 + hstepA, voffA);
            PG8_WAIT_V(8); PG8_WAIT_L(0); PG8_BAR; PG8_MMA(0, 0, At, B0); PG8_MMA(0, 1, At, B1); PG8_BAR; PG8_SCHED;
            PG8_LDA(At, 1, 1); PG8_STAGE(PG8_SB(1, 0), b3, voffB); PG8_STAGE(PG8_SB(1, 1), b3 + hstep, voffB); PG8_STAGE(PG8_SA(1, 0), a3, voffA);
            PG8_WAIT_V(8); PG8_WAIT_L(0); PG8_BAR; PG8_MMA(1, 0, At, B0); PG8_MMA(1, 1, At, B1); PG8_BAR; PG8_SCHED;
            } else {
            PG8_LDB(B0, 0, 0); PG8_SCHED; PG8_LDA(At, 0, 0); PG8_STAGE(PG8_SA(1, 1), a1 + hstepA, voffA);
            PG8_WAIT_L(8); PG8_BAR; PG8_WAIT_L(0); PG8_MMA(0, 0, At, B0); PG8_BAR; PG8_SCHED;
            PG8_LDB(B1, 0, 1); PG8_STAGE(PG8_SB(0, 0), b2, voffB);
            PG8_BAR; PG8_WAIT_L(0); PG8_MMA(0, 1, At, B1); PG8_BAR;
            PG8_LDA(At, 0, 1); PG8_STAGE(PG8_SA(0, 0), a2, voffA);
            PG8_BAR; PG8_WAIT_L(0); PG8_MMA(1, 0, At, B0); PG8_BAR; PG8_SCHED;
            PG8_STAGE(PG8_SB(0, 1), b2 + hstep, voffB);
            PG8_WAIT_V(6); PG8_BAR; PG8_MMA(1, 1, At, B1); PG8_BAR;
            PG8_LDB(B0, 1, 0); PG8_SCHED; PG8_LDA(At, 1, 0); PG8_STAGE(PG8_SA(0, 1), a2 + hstepA, voffA);
            PG8_WAIT_L(8); PG8_BAR; PG8_WAIT_L(0); PG8_MMA(0, 0, At, B0); PG8_BAR; PG8_SCHED;
            PG8_LDB(B1, 1, 1); PG8_STAGE(PG8_SB(1, 0), b3, voffB);
            PG8_BAR; PG8_WAIT_L(0); PG8_MMA(0, 1, At, B1); PG8_BAR;
            PG8_LDA(At, 1, 1); PG8_STAGE(PG8_SA(1, 0), a3, voffA);
            PG8_BAR; PG8_WAIT_L(0); PG8_MMA(1, 0, At, B0); PG8_BAR; PG8_SCHED;
            PG8_STAGE(PG8_SB(1, 1), b3 + hstep, voffB);
            PG8_WAIT_V(6); PG8_BAR; PG8_MMA(1, 1, At, B1); PG8_BAR;
            }
        }
        typename Epi::Pre pre_;
        if constexpr (!Epi::AFTER_DRAIN) E.pre(pre_, cur, wr, wc, fr, fq, lds);
        if constexpr (ALIGN_EPI) { if (wr == 0) PG8_BAR; }
        if constexpr (!Epi::AFTER_DRAIN) { E(acc, cur, wr, wc, fr, fq, pre_); S.done(cur); }
        if (!has_next) break;
#pragma unroll
        for (int a = 0; a < 2; ++a)
#pragma unroll
            for (int b = 0; b < 2; ++b)
#pragma unroll
                for (int m = 0; m < 4; ++m)
#pragma unroll
                    for (int n = 0; n < 2; ++n) acc[a][b][m][n] = (f32x4){0.f, 0.f, 0.f, 0.f};
        cur = nxt; cA = nA; cB = nB; ++ui;
        if constexpr (ALIGN_EPI) { if (wr == 1) PG8_BAR; }
    }
    if constexpr (Epi::AFTER_DRAIN) {
        typename Epi::Pre pre_;
        const bool pf = E.pre(pre_, cur, wr, wc, fr, fq);
        if (pf) asm volatile("s_waitcnt vmcnt(16)" ::: "memory"); else PG8_WAIT_V(0);
        if constexpr (!ALIGN_EPI) { if (wr == 0) PG8_BAR; }
        PG8_BAR;
        E.fused(acc, cur, wr, wc, fr, fq, lds, wid, lane, pre_, pf); S.done(cur);
    } else {
        PG8_WAIT_V(0);
        if constexpr (!ALIGN_EPI) { if (wr == 0) PG8_BAR; }
        PG8_BAR;
    }
#undef PG8_SA
#undef PG8_SB
#undef PG8_STAGE
#undef PG8_LDA
#undef PG8_LDB
#undef PG8_MMA
#undef PG8_WAIT_V
#undef PG8_WAIT_L
#undef PG8_BAR
#undef PG8_SCHED
}
}

struct WS {
    unsigned* bar;
    bf16* hb;
    float* ssq;
    float* ssq1;
    bf16* hid;
    bf16* u0;
    bf16* qkv0;
    bf16* hg;
    float* flog;
    float* cum;
    float* segtot;
    bf16* ycat;
    bf16* w1o;
    bf16* qmla;
    bf16* kvmla;
    bf16* kcb; bf16* vcb;
    float* s5e;
    float* cb1;
    int* bkt;
    float* tbg;
    float* ropet;
    bf16* hkv; float* pq;
    bf16* wt_c1k; bf16* wt_c1v;
    bf16* wA1; bf16* wA2; bf16* wB1; bf16* wB2;
    bf16* wt_in0; bf16* wt_out0; bf16* wt_glu; bf16* wt_in1; bf16* wt_uq; bf16* wt_ukv; bf16* wt_out1;
};
struct GemmP {
    const bf16* A; int lda; int amode; int acoff;
    const float* W; const float* W2; int ldw; int bmode; int bcoff;
    const float* gain;
    int M, N, K;
    const float* PQ; const float* cb1;
};
__device__ __forceinline__ bool a_valid(const GemmP& g, int m) { return g.amode == 0 ? true : ((m & 511) < 511); }
__device__ __forceinline__ const bf16* a_ptr(const GemmP& g, int m, int k) {
    if (g.amode == 0) return g.A + (size_t)m * g.lda + k;
    int bg = m >> 9, i = m & 511, b = bg >> 1, gq = bg & 1, l = k >> 6, d = k & 63;
    return g.A + (size_t)(b * S + 16 * i + l) * g.lda + g.acoff + gq * 64 + d;
}
__device__ __forceinline__ uint4 a_load8(const GemmP& g, int m, int k) {
    if (g.amode != 2) return *(const uint4*)a_ptr(g, m, k);
    const float* pp = g.PQ + (size_t)m * 256 + k; const float* qq = g.PQ + (size_t)(m + 1) * 256 + 128 + k; const float* bb = g.cb1 + k;
    const f32x4 p0 = *(const f32x4*)pp, p1 = *(const f32x4*)(pp + 4), q0 = *(const f32x4*)qq, q1 = *(const f32x4*)(qq + 4), b0 = *(const f32x4*)bb, b1 = *(const f32x4*)(bb + 4);
    const f32x4 x0 = p0 + q0 + b0, x1 = p1 + q1 + b1;
    return make_uint4(pk2(gelu_tanh(x0[0]), gelu_tanh(x0[1])), pk2(gelu_tanh(x0[2]), gelu_tanh(x0[3])), pk2(gelu_tanh(x1[0]), gelu_tanh(x1[1])), pk2(gelu_tanh(x1[2]), gelu_tanh(x1[3])));
}
__device__ __forceinline__ const float* b_col(const GemmP& g, int n) {
    if (g.bmode == 0) return g.W + g.bcoff + n;
    if (g.bmode == 1) { int blk = n >> 4; int j = (n >> 5) * 16 + (n & 15); return ((blk & 1) ? g.W2 : g.W) + j; }
    if (g.bmode == 2) { int hh = n / 96, c = n - hh * 96; if (c < 64) return g.W + n; int r = c - 64; return g.W + hh * 96 + 64 + (r & 1) * 16 + (r >> 1); }
      { if (n >= C_KR && n < C_KR + 32) { int r = n - C_KR; return g.W + C_KR + (r & 1) * 16 + (r >> 1); } return g.W + n; }
}

__device__ __forceinline__ float rstd4(const float* ssq, int m) { const f32x4 v = *(const f32x4*)(ssq + (size_t)m * 4); return rsqrtf(((v[0] + v[1]) + (v[2] + v[3])) * (1.0f / 1024.0f) + 1e-6f); }
__device__ __forceinline__ u32x4 pk8(f32x4 a, f32x4 b) { return (u32x4){pk2(a[0], a[1]), pk2(a[2], a[3]), pk2(b[0], b[1]), pk2(b[2], b[3])}; }
struct EpiFFN1 {
    static constexpr bool SSQ = false, RS4 = true; bf16* hid; const float* ssq;
    __device__ __forceinline__ float rowscale(int m) const { return rstd4(ssq, m); }
    __device__ __forceinline__ void oct2(int m, int j0, f32x4 g0, f32x4 g1, f32x4 u0, f32x4 u1) const { f32x4 o0, o1;
#pragma unroll
        for (int i = 0; i < 4; ++i) { o0[i] = g0[i] * sigmoidf_(g0[i]) * u0[i]; o1[i] = g1[i] * sigmoidf_(g1[i]) * u1[i]; }
        *(u32x4*)(hid + (size_t)m * FF + j0) = pk8(o0, o1); }
    __device__ __forceinline__ void rowdone(int, int, float) const {}
};
struct EpiRes {
    static constexpr bool SSQ = true; const float* hin32; float* hout32; bf16* hb; float* ssq; const float* fgain; unsigned* fcnt; float scale; int pad_;
    struct R8 { f32x4 a, b; };
    __device__ __forceinline__ R8 load8(int m, int n0) const { R8 r;
        if (hin32) { r.a = *(const f32x4*)(hin32 + (size_t)m * D + n0); r.b = *(const f32x4*)(hin32 + (size_t)m * D + n0 + 4); }
        else { const u32x4 w = *(const u32x4*)(hb + (size_t)m * D + n0);
            r.a = (f32x4){__uint_as_float(w[0] << 16), __uint_as_float(w[0] & 0xffff0000u), __uint_as_float(w[1] << 16), __uint_as_float(w[1] & 0xffff0000u)};
            r.b = (f32x4){__uint_as_float(w[2] << 16), __uint_as_float(w[2] & 0xffff0000u), __uint_as_float(w[3] << 16), __uint_as_float(w[3] & 0xffff0000u)}; }
        return r; }
    __device__ __forceinline__ float finish8(int m, int n0, R8 x, f32x4 v0, f32x4 v1) const {
        x.a += v0 * scale; x.b += v1 * scale;
        if (hout32) { *(f32x4*)(hout32 + (size_t)m * D + n0) = x.a; *(f32x4*)(hout32 + (size_t)m * D + n0 + 4) = x.b; } else *(u32x4*)(hb + (size_t)m * D + n0) = pk8(x.a, x.b);
        const f32x4 q = x.a * x.a + x.b * x.b; return (q[0] + q[1]) + (q[2] + q[3]); }
};
struct EpiWin0 {
    static constexpr bool SSQ = false, RS4 = true; bf16* u0; bf16* qkv0; const float* ssq;
    __device__ __forceinline__ float rowscale(int m) const { return rstd4(ssq, m); }
    __device__ __forceinline__ float oct(int m, int n0, f32x4 v0, f32x4 v1) const {
        if (n0 < 512) *(u32x4*)(u0 + (size_t)m * 512 + n0) = pk8(v0, v1); else *(u32x4*)(qkv0 + (size_t)m * 1536 + (n0 - 512)) = pk8(v0, v1);
        return 0.f; }
    __device__ __forceinline__ void rowdone(int, int, float) const {}
};
struct EpiGlu {
    static constexpr bool SSQ = false, RS4 = false; const bf16* hg; const float* bglu; bf16* ycat;
    __device__ __forceinline__ float rowscale(int) const { return 1.f; }
    __device__ __forceinline__ float oct(int m, int n0, f32x4 v0, f32x4 v1) const { f32x4 o0, o1; const u32x4 hv = *(const u32x4*)(hg + (size_t)m * 512 + n0); const f32x4 b0 = *(const f32x4*)(bglu + n0), b1 = *(const f32x4*)(bglu + n0 + 4);
        o0[0] = __uint_as_float(hv[0] << 16) * sigmoidf_(v0[0] + b0[0]); o0[1] = __uint_as_float(hv[0] & 0xffff0000u) * sigmoidf_(v0[1] + b0[1]);
        o0[2] = __uint_as_float(hv[1] << 16) * sigmoidf_(v0[2] + b0[2]); o0[3] = __uint_as_float(hv[1] & 0xffff0000u) * sigmoidf_(v0[3] + b0[3]);
        o1[0] = __uint_as_float(hv[2] << 16) * sigmoidf_(v1[0] + b1[0]); o1[1] = __uint_as_float(hv[2] & 0xffff0000u) * sigmoidf_(v1[1] + b1[1]);
        o1[2] = __uint_as_float(hv[3] << 16) * sigmoidf_(v1[2] + b1[2]); o1[3] = __uint_as_float(hv[3] & 0xffff0000u) * sigmoidf_(v1[3] + b1[3]);
        *(u32x4*)(ycat + (size_t)m * D + n0) = pk8(o0, o1); return 0.f; }
    __device__ __forceinline__ void rowdone(int, int, float) const {}
};
__device__ __forceinline__ void rope2(f32x4& v, int i0, int pos, const float* ropet) {
    const f32x4 cs = *(const f32x4*)(ropet + ((size_t)pos * 16 + i0) * 2);
    const float x1 = v[0], x2 = v[1], y1 = v[2], y2 = v[3];
    v[0] = x1 * cs[0] - x2 * cs[1]; v[1] = x2 * cs[0] + x1 * cs[1]; v[2] = y1 * cs[2] - y2 * cs[3]; v[3] = y2 * cs[2] + y1 * cs[3];
}
struct EpiWin1 {
    static constexpr bool SSQ = true, RS4 = true; bf16* w1o; const float* ssq; float* ssq1; const float* ropet; bf16* hkv;
    __device__ __forceinline__ float rowscale(int m) const { return rstd4(ssq, m); }
    __device__ __forceinline__ float oct(int m, int n0, f32x4 v0, f32x4 v1) const {
        if (n0 >= ODD_IN) return 0.f;
        const f32x4 q2 = v0 * v0 + v1 * v1; const float ss = (q2[0] + q2[1]) + (q2[2] + q2[3]);
        if (n0 >= C_KR && n0 < C_KR + 32) { rope2(v0, (n0 - C_KR) >> 1, m & (S - 1), ropet); rope2(v1, ((n0 - C_KR) >> 1) + 2, m & (S - 1), ropet); }
        if (n0 >= C_KC && n0 < C_KC + 256) { const int c = n0 - C_KC, kv = c >> 7, gq = (c >> 6) & 1, d = c & 63, bb = m >> 13, tl = m & (S - 1);
            *(u32x4*)(hkv + (size_t)kv * 2048 * 1024 + ((size_t)(bb * 2 + gq) * 512 + (tl >> 4)) * 1024 + (tl & 15) * 64 + d) = pk8(v0, v1); return ss; }
        *(u32x4*)(w1o + (size_t)m * LDW1 + n0) = pk8(v0, v1); return ss; }
    __device__ __forceinline__ void rowdone(int m, int cb, float ss) const { if (cb < 20) ssq1[(size_t)m * 32 + cb] = ss; }
};
struct EpiUq {
    static constexpr bool SSQ = false, RS4 = false; bf16* qmla; const float* ssq1; const float* ropet;
    __device__ __forceinline__ float rowscale(int m) const { const f32x4 a = *(const f32x4*)(ssq1 + (size_t)m * 32), b = *(const f32x4*)(ssq1 + (size_t)m * 32 + 4), c = *(const f32x4*)(ssq1 + (size_t)m * 32 + 8);
        const f32x4 t = a + b + c; return rsqrtf(((t[0] + t[1]) + (t[2] + t[3])) * (1.0f / 384.0f) + 1e-6f); }
    __device__ __forceinline__ float oct(int m, int n0, f32x4 v0, f32x4 v1) const { const int hh = n0 / 96, c = n0 - hh * 96;
        if (c >= 64) { rope2(v0, (c - 64) >> 1, m & (S - 1), ropet); rope2(v1, ((c - 64) >> 1) + 2, m & (S - 1), ropet); }
        *(u32x4*)(qmla + (size_t)m * 768 + n0) = pk8(v0, v1); return 0.f; }
    __device__ __forceinline__ void rowdone(int, int, float) const {}
};
struct EpiUkv {
    static constexpr bool SSQ = false, RS4 = false; bf16* kvmla; const float* ssq1;
    __device__ __forceinline__ float rowscale(int m) const { const f32x4 a = *(const f32x4*)(ssq1 + (size_t)m * 32 + 12), b = *(const f32x4*)(ssq1 + (size_t)m * 32 + 16);
        const f32x4 t = a + b; return rsqrtf(((t[0] + t[1]) + (t[2] + t[3])) * (1.0f / 256.0f) + 1e-6f); }
    __device__ __forceinline__ float oct(int m, int n0, f32x4 v0, f32x4 v1) const { *(u32x4*)(kvmla + (size_t)m * 1024 + n0) = pk8(v0, v1); return 0.f; }
    __device__ __forceinline__ void rowdone(int, int, float) const {}
};
struct EpiPQ {
    static constexpr bool SSQ = false, RS4 = false; float* pq;
    __device__ __forceinline__ float rowscale(int) const { return 1.f; }
    __device__ __forceinline__ float oct(int m, int n0, f32x4 v0, f32x4 v1) const { *(f32x4*)(pq + (size_t)m * 256 + n0) = v0; *(f32x4*)(pq + (size_t)m * 256 + n0 + 4) = v1; return 0.f; }
    __device__ __forceinline__ void rowdone(int, int, float) const {}
};
struct EpiCmp2 {
    static constexpr bool SSQ = false; bf16* outb;
    __device__ __forceinline__ float rowscale(int) const { return 1.f; }
    __device__ __forceinline__ float quad(int m, int n0, f32x4 v) const { if (n0 < 64) *(uint2*)(outb + (size_t)m * 64 + n0) = pk4(v); return 0.f; }
    __device__ __forceinline__ void rowdone(int, int, float) const {}
};
template <class E, bool DUAL>
struct PgEpi {
    static constexpr bool PERM = true, AFTER_DRAIN = false; E e;
    using Pre = f32x4[2][4];
    static constexpr bool RSDMA = E::RS4;
    __device__ __forceinline__ const float* rs_src() const { if constexpr (E::RS4) return e.ssq; else return nullptr; }
    __device__ __forceinline__ void pre(Pre& p, const pg8::Unit&, int wr, int, int fr, int, PG8_LAS unsigned char* lds) const {
        if constexpr (E::RS4) {
#pragma unroll
            for (int ai = 0; ai < 2; ++ai)
#pragma unroll
                for (int m = 0; m < 4; ++m) p[ai][m] = *(const PG8_LAS f32x4*)(lds + pg8::STAGE_BYTES + (ai * 128 + wr * 64 + m * 16 + fr) * 16);
        }
    }
    __device__ __forceinline__ void operator()(const f32x4 (&acc)[2][2][4][2], const pg8::Unit& u, int wr, int wc, int fr, int fq, const Pre& p) const {
#pragma unroll
        for (int ai = 0; ai < 2; ++ai) {
            float rs[4];
#pragma unroll
            for (int m = 0; m < 4; ++m) {
                if constexpr (E::RS4) { const f32x4 v = p[ai][m]; rs[m] = __builtin_amdgcn_rsqf(((v[0] + v[1]) + (v[2] + v[3])) * (1.0f / 1024.0f) + 1e-6f); }
                else rs[m] = e.rowscale(u.pm * 256 + ai * 128 + wr * 64 + m * 16 + fr); }
#pragma unroll
            for (int m = 0; m < 4; ++m) { const int row = u.pm * 256 + ai * 128 + wr * 64 + m * 16 + fr; const float rsv = rs[m];
                if constexpr (DUAL) e.oct2(row, u.pn * 128 + wc * 32 + fq * 8, acc[ai][0][m][0] * rsv, acc[ai][0][m][1] * rsv, acc[ai][1][m][0] * rsv, acc[ai][1][m][1] * rsv);
                else {
#pragma unroll
                    for (int bj = 0; bj < 2; ++bj) { float ss = e.oct(row, u.pn * 256 + bj * 128 + wc * 32 + fq * 8, acc[ai][bj][m][0] * rsv, acc[ai][bj][m][1] * rsv);
                        if constexpr (E::SSQ) { ss = xrow16_sum(ss); if (fq == 0) e.rowdone(row, (u.pn * 2 + bj) * 4 + wc, ss); } } }
                asm volatile("" ::: "memory"); } }
    }
};
struct PgEpiRes {
    static constexpr bool PERM = true, AFTER_DRAIN = true, RSDMA = false; EpiRes e;
    using Pre = u32x4[8][2];
    __device__ __forceinline__ bool pre(Pre& p, const pg8::Unit& u, int wr, int wc, int fr, int fq) const {
        if (e.hin32) return false;
#pragma unroll
        for (int g = 0; g < 8; ++g) { const int row = u.pm * 256 + (g >> 2) * 128 + wr * 64 + (g & 3) * 16 + fr;
#pragma unroll
            for (int bj = 0; bj < 2; ++bj) p[g][bj] = *(const u32x4*)(e.hb + (size_t)row * D + u.pn * 256 + bj * 128 + wc * 32 + fq * 8); }
        return true;
    }
    __device__ __forceinline__ void fused(f32x4 (&acc)[2][2][4][2], const pg8::Unit& u, int wr, int wc, int fr, int fq, PG8_LAS unsigned char* lds, int wid, int lane, const Pre& p, bool pf) const {
        PG8_LAS float* red = (PG8_LAS float*)lds;
        const bool fin = e.fgain != nullptr;
        if (pf) {
#pragma unroll
            for (int g = 0; g < 8; ++g) { const int ai = g >> 2, m = g & 3, rl = ai * 128 + wr * 64 + m * 16 + fr, row = u.pm * 256 + rl; float ss = 0.f;
#pragma unroll
                for (int bj = 0; bj < 2; ++bj) { const u32x4 w = p[g][bj]; EpiRes::R8 x;
                    x.a = (f32x4){__uint_as_float(w[0] << 16), __uint_as_float(w[0] & 0xffff0000u), __uint_as_float(w[1] << 16), __uint_as_float(w[1] & 0xffff0000u)};
                    x.b = (f32x4){__uint_as_float(w[2] << 16), __uint_as_float(w[2] & 0xffff0000u), __uint_as_float(w[3] << 16), __uint_as_float(w[3] & 0xffff0000u)};
                    x.a += acc[ai][bj][m][0] * e.scale; x.b += acc[ai][bj][m][1] * e.scale;
                    if (fin) { acc[ai][bj][m][0] = x.a; acc[ai][bj][m][1] = x.b; }
                    else *(u32x4*)(e.hb + (size_t)row * D + u.pn * 256 + bj * 128 + wc * 32 + fq * 8) = pk8(x.a, x.b);
                    const f32x4 q = x.a * x.a + x.b * x.b; ss += (q[0] + q[1]) + (q[2] + q[3]); }
                ss = xrow16_sum(ss); if (fq == 0) red[rl * 4 + wc] = ss; }
        } else {
        EpiRes::R8 xa[2], xb[2];
#define RES_LOAD(dst_, g_) do { const int ai_ = (g_) >> 2, m_ = (g_) & 3; const int row_ = u.pm * 256 + ai_ * 128 + wr * 64 + m_ * 16 + fr; \
            _Pragma("unroll") for (int bj = 0; bj < 2; ++bj) dst_[bj] = e.load8(row_, u.pn * 256 + bj * 128 + wc * 32 + fq * 8); } while (0)
#define RES_DO(src_, g_) do { const int ai_ = (g_) >> 2, m_ = (g_) & 3; const int rl_ = ai_ * 128 + wr * 64 + m_ * 16 + fr, row_ = u.pm * 256 + rl_; float ss_ = 0.f; \
            _Pragma("unroll") for (int bj = 0; bj < 2; ++bj) ss_ += e.finish8(row_, u.pn * 256 + bj * 128 + wc * 32 + fq * 8, src_[bj], acc[ai_][bj][m_][0], acc[ai_][bj][m_][1]); \
            ss_ = xrow16_sum(ss_); if (fq == 0) red[rl_ * 4 + wc] = ss_; } while (0)
        RES_LOAD(xa, 0);
#pragma unroll
        for (int gp = 0; gp < 8; gp += 2) {
            RES_LOAD(xb, gp + 1); RES_DO(xa, gp); asm volatile("" ::: "memory");
            if (gp + 2 < 8) RES_LOAD(xa, gp + 2);
            RES_DO(xb, gp + 1); asm volatile("" ::: "memory");
        }
#undef RES_LOAD
#undef RES_DO
        }
        __syncthreads();
        const int t = threadIdx.x;
        if (t < 256) { const f32x4 r = *(const PG8_LAS f32x4*)(red + t * 4); const float sv = (r[0] + r[1]) + (r[2] + r[3]); float* sp_ = e.ssq + (size_t)(u.pm * 256 + t) * 4 + u.pn;
            if (fin) __hip_atomic_store(sp_, sv, __ATOMIC_RELAXED, __HIP_MEMORY_SCOPE_AGENT); else *sp_ = sv; }
        if (fin) {
            PG8_LAS float* rsl = red + 1024;
            unsigned* cnt = e.fcnt + u.pm * 64;
            asm volatile("s_waitcnt vmcnt(0)" ::: "memory");
            __syncthreads();
            if (t == 0) { __hip_atomic_fetch_add(cnt, 1u, __ATOMIC_RELAXED, __HIP_MEMORY_SCOPE_AGENT); unsigned sp = 0u;
                while (__hip_atomic_load(cnt, __ATOMIC_RELAXED, __HIP_MEMORY_SCOPE_AGENT) < 4u) { __builtin_amdgcn_s_sleep(1); if (++sp > (1u << 24)) break; }
                __builtin_amdgcn_fence(__ATOMIC_ACQUIRE, "agent"); asm volatile("s_waitcnt vmcnt(0)" ::: "memory"); }
            __syncthreads();
            if (t < 256) { const float* sp_ = e.ssq + (size_t)(u.pm * 256 + t) * 4;
                const float s0 = __hip_atomic_load(sp_, __ATOMIC_RELAXED, __HIP_MEMORY_SCOPE_AGENT), s1 = __hip_atomic_load(sp_ + 1, __ATOMIC_RELAXED, __HIP_MEMORY_SCOPE_AGENT),
                            s2 = __hip_atomic_load(sp_ + 2, __ATOMIC_RELAXED, __HIP_MEMORY_SCOPE_AGENT), s3 = __hip_atomic_load(sp_ + 3, __ATOMIC_RELAXED, __HIP_MEMORY_SCOPE_AGENT);
                rsl[t] = rsqrtf(((s0 + s1) + (s2 + s3)) * (1.0f / 1024.0f) + 1e-6f); }
            __syncthreads();
            f32x4 gn[2][2];
#pragma unroll
            for (int bj = 0; bj < 2; ++bj) { const int n0 = u.pn * 256 + bj * 128 + wc * 32 + fq * 8; gn[bj][0] = *(const f32x4*)(e.fgain + n0); gn[bj][1] = *(const f32x4*)(e.fgain + n0 + 4); }
#pragma unroll
            for (int g = 0; g < 8; ++g) { const int ai = g >> 2, m = g & 3, rl = ai * 128 + wr * 64 + m * 16 + fr; const float rs = rsl[rl]; float* op = e.hout32 + (size_t)(u.pm * 256 + rl) * D + u.pn * 256 + wc * 32 + fq * 8;
#pragma unroll
                for (int bj = 0; bj < 2; ++bj) { *(f32x4*)(op + bj * 128) = acc[ai][bj][m][0] * rs * gn[bj][0]; *(f32x4*)(op + bj * 128 + 4) = acc[ai][bj][m][1] * rs * gn[bj][1]; } }
        }
    }
};
__device__ __forceinline__ void res_gemm(const bf16* A, int lda, const bf16* Bt, int K, const EpiRes& e, char* smem, int G, int bid) {
    asm volatile("" : "+s"(K), "+s"(lda));
    pg8::Gemm g{A, Bt, T, D, K, lda}; pg8::StaticOrder so; so.init(T, D, G, bid);
    const PgEpiRes pe{e};
    pg8::gemm_phase<PgEpiRes, pg8::StaticOrder, false, true>((PG8_LAS unsigned char*)smem, g, so, pe);
}
template <class E, bool DUAL>
__device__ __forceinline__ void big_gemm(const bf16* A, int lda, const bf16* Bt, int M, int N, int K, const E& e, char* smem, int G, int bid) {
    asm volatile("" : "+s"(K), "+s"(lda), "+s"(N));
    pg8::Gemm g{A, Bt, M, N, K, lda}; pg8::StaticOrder so; so.init(M, N, G, bid);
    const PgEpi<E, DUAL> pe{e};
    pg8::gemm_phase<PgEpi<E, DUAL>, pg8::StaticOrder, true, true>((PG8_LAS unsigned char*)smem, g, so, pe);
}

constexpr int G_LDS = 72;
constexpr int G_SMEM = 2 * 128 * G_LDS * 2;
template <class Epi, bool DUAL>
__device__ __forceinline__ void gemm_tile(const GemmP& g, const Epi& e, int tm, int tn, bf16* smem) {
    bf16* As = smem; bf16* Bs = smem + 128 * G_LDS;
    int tid_ = threadIdx.x & 255; asm volatile("" : "+v"(tid_)); const int tid = tid_, lane = tid & 63, wave = tid >> 6, wm = wave >> 1, wn = wave & 1;
    const int m0 = tm * 128, n0 = tn * 128;
    const int bn = tid & 127, bkh = tid >> 7;
    const bool bvalid = (n0 + bn) < g.N;
    const float* bcol = b_col(g, bvalid ? n0 + bn : 0);
    uint4 ra[4]; float rb[32];
    const int nkt = g.K / 64;
    auto load_tile = [&](int kt) {
#pragma unroll
        for (int i = 0; i < 4; ++i) { int c = tid + i * 256, row = c >> 3, kc = c & 7; int m = m0 + row;
            ra[i] = a_valid(g, m) ? a_load8(g, m, kt * 64 + kc * 8) : make_uint4(0, 0, 0, 0); }
        const float* bp = bcol + (size_t)(kt * 64 + bkh * 32) * g.ldw;
#pragma unroll
        for (int j = 0; j < 32; ++j) rb[j] = bvalid ? bp[(size_t)j * g.ldw] : 0.f;
        if (g.gain) { const float* gp = g.gain + kt * 64 + bkh * 32;
#pragma unroll
            for (int j = 0; j < 32; ++j) rb[j] *= gp[j]; }
    };
    auto store_tile = [&]() {
#pragma unroll
        for (int i = 0; i < 4; ++i) { int c = tid + i * 256, row = c >> 3, kc = c & 7; *(uint4*)(As + row * G_LDS + kc * 8) = ra[i]; }
#pragma unroll
        for (int q = 0; q < 4; ++q) { uint4 w;
            w.x = f2bf(rb[q * 8 + 0]) | ((unsigned)f2bf(rb[q * 8 + 1]) << 16); w.y = f2bf(rb[q * 8 + 2]) | ((unsigned)f2bf(rb[q * 8 + 3]) << 16);
            w.z = f2bf(rb[q * 8 + 4]) | ((unsigned)f2bf(rb[q * 8 + 5]) << 16); w.w = f2bf(rb[q * 8 + 6]) | ((unsigned)f2bf(rb[q * 8 + 7]) << 16);
            *(uint4*)(Bs + bn * G_LDS + bkh * 32 + q * 8) = w; }
    };
    f32x4 acc[4][4];
#pragma unroll
    for (int i = 0; i < 4; ++i)
#pragma unroll
        for (int j = 0; j < 4; ++j) acc[i][j] = (f32x4){0.f, 0.f, 0.f, 0.f};
    load_tile(0);
    for (int kt = 0; kt < nkt; ++kt) {
        __syncthreads();
        store_tile();
        __syncthreads();
        if (kt + 1 < nkt) load_tile(kt + 1);
#pragma unroll
        for (int kk = 0; kk < 2; ++kk) {
            bf16x8 a[4], b[4];
#pragma unroll
            for (int i = 0; i < 4; ++i) a[i] = *(const bf16x8*)(As + (wm * 64 + i * 16 + (lane & 15)) * G_LDS + kk * 32 + (lane >> 4) * 8);
#pragma unroll
            for (int j = 0; j < 4; ++j) b[j] = *(const bf16x8*)(Bs + (wn * 64 + j * 16 + (lane & 15)) * G_LDS + kk * 32 + (lane >> 4) * 8);
#pragma unroll
            for (int i = 0; i < 4; ++i)
#pragma unroll
                for (int j = 0; j < 4; ++j) acc[i][j] = __builtin_amdgcn_mfma_f32_16x16x32_bf16(b[j], a[i], acc[i][j], 0, 0, 0);
        }
    }
#pragma unroll
    for (int i = 0; i < 4; ++i) { const int m = m0 + wm * 64 + i * 16 + (lane & 15); const float rsv = e.rowscale(m); float ss = 0.f;
        if constexpr (DUAL) {
#pragma unroll
            for (int jj = 0; jj < 2; ++jj) ss += e.quad2(m, tn * 64 + wn * 32 + jj * 16 + (lane >> 4) * 4, acc[i][2 * jj] * rsv, acc[i][2 * jj + 1] * rsv);
        } else {
#pragma unroll
            for (int j = 0; j < 4; ++j) ss += e.quad(m, n0 + wn * 64 + j * 16 + (lane >> 4) * 4, acc[i][j] * rsv);
        }
        if constexpr (Epi::SSQ) { ss = xrow16_sum(ss); if ((lane >> 4) == 0) e.rowdone(m, 0, ss); }
    }
}


struct AttnP {
    const bf16* q; int ldq; const bf16* k; int ldk; const bf16* v; int ldv; const bf16* k2;
    const float* cum; const float* relb; const int* bkt; const float* tbg;
    const bf16* gl; const float* bgate; bf16* out; int ldo; const float* segtot;
    const bf16* kw; const bf16* vw; const bf16* kcb; const bf16* vcb;
};

constexpr int IMPS = 129, YST = 68;
constexpr int KB64 = 64 * 80 * 2, KB96 = 64 * 112 * 2, VBUF = 64 * 80 * 2;
constexpr int OFF_TB = 0, OFF_CKS = 4096, OFF_RING = OFF_CKS + 4 * 256, OFF_IMP = OFF_RING + 4 * KB64 + 4 * VBUF, OFF_SELW = OFF_IMP + 2 * 64 * IMPS * 4, OFF_Y = OFF_IMP  ,
              FL_SMEM = OFF_Y + 8 * 32 * YST * 4;
static_assert(OFF_RING + 4 * KB96 + 4 * VBUF <= FL_SMEM && OFF_SELW + 64 * 16 <= FL_SMEM && FL_SMEM + 16 <= 160 * 1024, "attention LDS map");
__device__ __forceinline__ float cum_at(const float* cum, const float (&pre8)[8], size_t rowb, int t, int hq) { return cum[(rowb + t) * 8 + hq] + pre8[t >> 10]; }
struct FCtx { int b, hq, hkv, qw0, qb_lo, qb_hi; };

template <int NKS, int KST>
__device__ __forceinline__ void qk_tile(const bf16* Ks, const bf16x8 (&qf)[2][NKS], f32x4 (&sc)[2][4], int l15, int quad) {
#pragma unroll
    for (int qt = 0; qt < 2; ++qt)
#pragma unroll
        for (int kt = 0; kt < 4; ++kt) sc[qt][kt] = (f32x4){0.f, 0.f, 0.f, 0.f};
    __builtin_amdgcn_s_setprio(1);
#pragma unroll
    for (int ks = 0; ks < NKS; ++ks)
#pragma unroll
        for (int kt = 0; kt < 4; ++kt) { const bf16x8 kf = *(const bf16x8*)(Ks + (kt * 16 + l15) * KST + ks * 32 + quad * 8);
#pragma unroll
            for (int qt = 0; qt < 2; ++qt) sc[qt][kt] = __builtin_amdgcn_mfma_f32_16x16x32_bf16(kf, qf[qt][ks], sc[qt][kt], 0, 0, 0); }
    __builtin_amdgcn_s_setprio(0);
}
__device__ __forceinline__ void pv_tile(const bf16* Vs, const unsigned (&pb)[2][4][2], f32x4 (&o)[2][4], int lane) {
    constexpr int VST = 80; const int l15 = lane & 15, quad = lane >> 4;
    __builtin_amdgcn_s_setprio(1);
#pragma unroll
    for (int ks2 = 0; ks2 < 2; ++ks2) {
        bf16x8 pf[2];
#pragma unroll
        for (int qt = 0; qt < 2; ++qt) { const u32x4 t4 = {pb[qt][2 * ks2][0], pb[qt][2 * ks2][1], pb[qt][2 * ks2 + 1][0], pb[qt][2 * ks2 + 1][1]}; pf[qt] = __builtin_bit_cast(bf16x8, t4); }
#pragma unroll
        for (int dvt = 0; dvt < 4; ++dvt) {
            const bf16* a0 = Vs + (ks2 * 32 + quad * 4 + (l15 >> 2)) * VST + dvt * 16 + (lane & 3) * 4;
            const s16x4 v0 = __builtin_amdgcn_ds_read_tr16_b64_v4i16((LDS_AS s16x4*)a0);
            const s16x4 v1 = __builtin_amdgcn_ds_read_tr16_b64_v4i16((LDS_AS s16x4*)(a0 + 16 * VST));
            bf16x8 vf; vf[0] = v0[0]; vf[1] = v0[1]; vf[2] = v0[2]; vf[3] = v0[3]; vf[4] = v1[0]; vf[5] = v1[1]; vf[6] = v1[2]; vf[7] = v1[3];
#pragma unroll
            for (int qt = 0; qt < 2; ++qt) o[qt][dvt] = __builtin_amdgcn_mfma_f32_16x16x32_bf16(vf, pf[qt], o[qt][dvt], 0, 0, 0);
        }
    }
    __builtin_amdgcn_s_setprio(0);
}

template <int CTRL> __device__ __forceinline__ float dppf(float x) { return __builtin_bit_cast(float, __builtin_amdgcn_mov_dpp(__builtin_bit_cast(int, x), CTRL, 0xf, 0xf, true)); }
template <int CTRL> __device__ __forceinline__ int dppi(int x) { return __builtin_amdgcn_mov_dpp(x, CTRL, 0xf, 0xf, true); }
constexpr int DPP_XOR1 = 0xB1, DPP_XOR2 = 0x4E, DPP_HMIRROR = 0x141;
template <int WHICH>
__device__ __forceinline__ void qk_tile_sel(const bf16* Ks, const bf16x8 (&qf)[2][2], f32x4 (&sc)[2][4], int l15, int quad) {
    constexpr int KST = 80;
#pragma unroll
    for (int qt = 0; qt < 2; ++qt)
#pragma unroll
        for (int kt = 0; kt < 4; ++kt) sc[qt][kt] = (f32x4){0.f, 0.f, 0.f, 0.f};
#pragma unroll
    for (int ks = 0; ks < 2; ++ks)
#pragma unroll
        for (int kt = 0; kt < 4; ++kt) { const bf16x8 kf = *(const bf16x8*)(Ks + (kt * 16 + l15) * KST + ks * 32 + quad * 8);
            if (WHICH != 2) sc[0][kt] = __builtin_amdgcn_mfma_f32_16x16x32_bf16(kf, qf[0][ks], sc[0][kt], 0, 0, 0);
            if (WHICH != 1) sc[1][kt] = __builtin_amdgcn_mfma_f32_16x16x32_bf16(kf, qf[1][ks], sc[1][kt], 0, 0, 0); }
}
__device__ __forceinline__ void qk_tile_en(const bf16* Ks, const bf16x8 (&qf)[2][2], f32x4 (&sc)[2][4], int l15, int quad, bool e0, bool e1) {
    if (e0 && e1) qk_tile_sel<0>(Ks, qf, sc, l15, quad); else if (e0) qk_tile_sel<1>(Ks, qf, sc, l15, quad); else qk_tile_sel<2>(Ks, qf, sc, l15, quad);
}
template <int WHICH>
__device__ __forceinline__ void pv_tile_sel(const bf16* Vs, const unsigned (&pb)[2][4][2], f32x4 (&o)[2][4], int lane) {
    constexpr int VST = 80; const int l15 = lane & 15, quad = lane >> 4;
#pragma unroll
    for (int ks2 = 0; ks2 < 2; ++ks2) {
        bf16x8 pf[2];
#pragma unroll
        for (int qt = 0; qt < 2; ++qt) { const u32x4 t4 = {pb[qt][2 * ks2][0], pb[qt][2 * ks2][1], pb[qt][2 * ks2 + 1][0], pb[qt][2 * ks2 + 1][1]}; pf[qt] = __builtin_bit_cast(bf16x8, t4); }
#pragma unroll
        for (int dvt = 0; dvt < 4; ++dvt) {
            const bf16* a0 = Vs + (ks2 * 32 + quad * 4 + (l15 >> 2)) * VST + dvt * 16 + (lane & 3) * 4;
            const s16x4 v0 = __builtin_amdgcn_ds_read_tr16_b64_v4i16((LDS_AS s16x4*)a0);
            const s16x4 v1 = __builtin_amdgcn_ds_read_tr16_b64_v4i16((LDS_AS s16x4*)(a0 + 16 * VST));
            bf16x8 vf; vf[0] = v0[0]; vf[1] = v0[1]; vf[2] = v0[2]; vf[3] = v0[3]; vf[4] = v1[0]; vf[5] = v1[1]; vf[6] = v1[2]; vf[7] = v1[3];
            if (WHICH != 2) o[0][dvt] = __builtin_amdgcn_mfma_f32_16x16x32_bf16(vf, pf[0], o[0][dvt], 0, 0, 0);
            if (WHICH != 1) o[1][dvt] = __builtin_amdgcn_mfma_f32_16x16x32_bf16(vf, pf[1], o[1][dvt], 0, 0, 0);
        }
    }
}
__device__ __forceinline__ void pv_tile_en(const bf16* Vs, const unsigned (&pb)[2][4][2], f32x4 (&o)[2][4], int lane, bool e0, bool e1) {
    if (e0 && e1) pv_tile_sel<0>(Vs, pb, o, lane); else if (e0) pv_tile_sel<1>(Vs, pb, o, lane); else pv_tile_sel<2>(Vs, pb, o, lane);
}

template <int MODE>
__device__ __forceinline__ void fl_tile(char* smem, int tile, int cur, int qw0, int qr0, int qr1, int hl, int l15, int quad, int lane, float SL, float c31, const float (&cq)[2],
                                        const u32x4 mwA, const u32x4 mwB, const bf16x8 (&qf)[2][(MODE == 1) ? 3 : 2], float (&m)[2], float (&l)[2], f32x4 (&o)[2][4]) {
    constexpr bool NM = (MODE >= 2);
    constexpr int DK = (MODE == 1) ? 96 : 64, KST = DK + 16, NKS = DK / 32, QSPAN = NM ? 8 : 32;
    const float* tb = (const float*)(smem + OFF_TB);
    const int kbase = tile * 64;
    bool skip = (kbase > qw0 + QSPAN - 1) || (MODE == 2 && kbase + 63 < qw0 - 511);
    bool bit0 = true, bit1 = true, en0 = true, en1 = true;
    if (MODE == 3) { const unsigned wa = (tile < 32) ? mwA[0] : (tile < 64) ? mwA[1] : (tile < 96) ? mwA[2] : mwA[3], wb = (tile < 32) ? mwB[0] : (tile < 64) ? mwB[1] : (tile < 96) ? mwB[2] : mwB[3];
        bit0 = (wa >> (tile & 31)) & 1u; bit1 = (wb >> (tile & 31)) & 1u;
        en0 = __builtin_amdgcn_ballot_w64(bit0) != 0ull; en1 = __builtin_amdgcn_ballot_w64(bit1) != 0ull; skip = skip || !(en0 || en1); }
    if (skip) return;
    constexpr int KB = (MODE == 1) ? KB96 : KB64;
    const bf16* Ks = (const bf16*)(smem + OFF_RING + cur * KB); const bf16* Vs = (const bf16*)(smem + OFF_RING + 4 * KB + cur * VBUF); const float* cks = (const float*)(smem + OFF_CKS) + cur * 64;
    f32x4 sc[2][4];
    if constexpr (MODE == 3) qk_tile_en(Ks, qf, sc, l15, quad, en0, en1); else qk_tile<NKS, KST>(Ks, qf, sc, l15, quad);
    unsigned pb[2][4][2];
    const bool edge = (kbase + 63 > qw0) || (MODE == 2 && kbase < qw0 + QSPAN - 1 - 511);
    const bool near = (MODE >= 2) && (kbase + 63 >= qw0 - 127);
    if (edge || near || MODE == 0) {
        f32x4 ckv[4];
        if (MODE == 0) {
#pragma unroll
            for (int kt = 0; kt < 4; ++kt) ckv[kt] = *(const f32x4*)(cks + kt * 16 + quad * 4); }
#pragma unroll
        for (int qt = 0; qt < 2; ++qt) {
            if (MODE == 3 && !(qt ? en1 : en0)) continue;
            const int q = qt ? qr1 : qr0; const bool bit = qt ? bit1 : bit0;
            float mx = -INFINITY;
#pragma unroll
            for (int kt = 0; kt < 4; ++kt)
#pragma unroll
                for (int r = 0; r < 4; ++r) { const int key = kbase + kt * 16 + quad * 4 + r; float bs = 0.f;
                    if (MODE == 0) bs = cq[qt] - ckv[kt][r];
                    if (MODE >= 2) { const int dd = q - key; bs = c31; if (near) { int di = dd < 0 ? 0 : (dd > 127 ? 127 : dd); const float tv = tb[hl * 136 + di]; bs = dd < 128 ? tv : c31; } }
                    float x = __builtin_fmaf(sc[qt][kt][r], SL, bs);
                    if (MODE != 0 || edge) { bool valid = key <= q; if (MODE == 2) valid = valid && (q - key < 512); if (MODE == 3) valid = valid && bit; x = valid ? x : -INFINITY; }
                    sc[qt][kt][r] = x; mx = fmaxf(mx, x); }
            mx = xrow16_max(mx);
            const float mn = fmaxf(m[qt], mx), ms = (mn == -INFINITY) ? 0.f : mn;
            const float alpha = __builtin_amdgcn_exp2f(m[qt] - ms); m[qt] = mn;
            float rsum = 0.f;
#pragma unroll
            for (int kt = 0; kt < 4; ++kt) { const float e0 = __builtin_amdgcn_exp2f(sc[qt][kt][0] - ms), e1 = __builtin_amdgcn_exp2f(sc[qt][kt][1] - ms), e2 = __builtin_amdgcn_exp2f(sc[qt][kt][2] - ms), e3 = __builtin_amdgcn_exp2f(sc[qt][kt][3] - ms);
                rsum += (e0 + e1) + (e2 + e3); pb[qt][kt][0] = pk2(e0, e1); pb[qt][kt][1] = pk2(e2, e3); }
            l[qt] = l[qt] * alpha + rsum;
            if (__builtin_amdgcn_ballot_w64(alpha != 1.0f) != 0ull) {
#pragma unroll
                for (int d = 0; d < 4; ++d) o[qt][d] *= alpha; }
        }
    } else {
#pragma unroll
        for (int qt = 0; qt < 2; ++qt) {
            if (MODE == 3 && !(qt ? en1 : en0)) continue;
            float bq = 0.f;
            if (MODE >= 2) bq = c31;
            if (MODE == 3) { if (!(qt ? bit1 : bit0)) bq = -INFINITY; }
            float mx = -INFINITY;
#pragma unroll
            for (int kt = 0; kt < 4; ++kt) mx = fmaxf(fmaxf(mx, fmaxf(sc[qt][kt][0], sc[qt][kt][1])), fmaxf(sc[qt][kt][2], sc[qt][kt][3]));
            mx = xrow16_max(mx);
            const float xm = __builtin_fmaf(mx, SL, bq);
            const float mn = fmaxf(m[qt], xm), ms = (mn == -INFINITY) ? 0.f : mn;
            const float alpha = __builtin_amdgcn_exp2f(m[qt] - ms); m[qt] = mn;
            const float off = bq - ms; float rsum = 0.f;
#pragma unroll
            for (int kt = 0; kt < 4; ++kt) { const float e0 = __builtin_amdgcn_exp2f(__builtin_fmaf(sc[qt][kt][0], SL, off)), e1 = __builtin_amdgcn_exp2f(__builtin_fmaf(sc[qt][kt][1], SL, off)),
                                                         e2 = __builtin_amdgcn_exp2f(__builtin_fmaf(sc[qt][kt][2], SL, off)), e3 = __builtin_amdgcn_exp2f(__builtin_fmaf(sc[qt][kt][3], SL, off));
                rsum += (e0 + e1) + (e2 + e3); pb[qt][kt][0] = pk2(e0, e1); pb[qt][kt][1] = pk2(e2, e3); }
            l[qt] = l[qt] * alpha + rsum;
            if (__builtin_amdgcn_ballot_w64(alpha != 1.0f) != 0ull) {
#pragma unroll
                for (int d = 0; d < 4; ++d) o[qt][d] *= alpha; }
        }
    }
    if constexpr (MODE == 3) pv_tile_en(Vs, pb, o, lane, en0, en1); else pv_tile(Vs, pb, o, lane);
}

template <int MODE>
__device__ __forceinline__ bool fl_tile2(char* smem, int tile, int cur, int qw0, int hl, int l15, int quad, int lane, float SL, float c31,
                                         const u32x4 mwA, const u32x4 mwB, const bf16x8 (&qf)[2][(MODE == 1) ? 3 : 2], float (&m)[2], float (&l)[2], f32x4 (&o)[2][4]) {
    static_assert(MODE == 1 || MODE == 3, "merged step: MLA and NSA-select only");
    constexpr bool NM = (MODE >= 2);
    constexpr int DK = (MODE == 1) ? 96 : 64, KST = DK + 16, NKS = DK / 32, QSPAN = NM ? 8 : 32, KB = (MODE == 1) ? KB96 : KB64;
    const int kbase = tile * 64;
    if (kbase + 127 > qw0) return false;
    if (NM && kbase + 127 >= qw0 - 127) return false;
    bool b00 = true, b01 = true, b10 = true, b11 = true, e00 = true, e01 = true, e10 = true, e11 = true;
    if (MODE == 3) { const int t1 = tile + 1;
        const unsigned wa0 = (tile < 32) ? mwA[0] : (tile < 64) ? mwA[1] : (tile < 96) ? mwA[2] : mwA[3], wb0 = (tile < 32) ? mwB[0] : (tile < 64) ? mwB[1] : (tile < 96) ? mwB[2] : mwB[3];
        const unsigned wa1 = (t1 < 32) ? mwA[0] : (t1 < 64) ? mwA[1] : (t1 < 96) ? mwA[2] : mwA[3], wb1 = (t1 < 32) ? mwB[0] : (t1 < 64) ? mwB[1] : (t1 < 96) ? mwB[2] : mwB[3];
        b00 = (wa0 >> (tile & 31)) & 1u; b10 = (wb0 >> (tile & 31)) & 1u; b01 = (wa1 >> (t1 & 31)) & 1u; b11 = (wb1 >> (t1 & 31)) & 1u;
        e00 = __builtin_amdgcn_ballot_w64(b00) != 0ull; e01 = __builtin_amdgcn_ballot_w64(b01) != 0ull; e10 = __builtin_amdgcn_ballot_w64(b10) != 0ull; e11 = __builtin_amdgcn_ballot_w64(b11) != 0ull;
        if (!(e00 || e01 || e10 || e11)) return true; }
    const bf16* Ks0 = (const bf16*)(smem + OFF_RING + cur * KB); const bf16* Ks1 = Ks0 + KB / 2;
    const bf16* Vs0 = (const bf16*)(smem + OFF_RING + 4 * KB + cur * VBUF); const bf16* Vs1 = Vs0 + VBUF / 2;
    f32x4 sc[2][8];
#pragma unroll
    for (int qt = 0; qt < 2; ++qt)
#pragma unroll
        for (int k8 = 0; k8 < 8; ++k8) sc[qt][k8] = (f32x4){0.f, 0.f, 0.f, 0.f};
#define QK_PART(qt_, t_, Ks_) do { _Pragma("unroll") for (int ks = 0; ks < NKS; ++ks) _Pragma("unroll") for (int kt = 0; kt < 4; ++kt) { \
            const bf16x8 kf = *(const bf16x8*)((Ks_) + (kt * 16 + l15) * KST + ks * 32 + quad * 8); sc[qt_][(t_) * 4 + kt] = __builtin_amdgcn_mfma_f32_16x16x32_bf16(kf, qf[qt_][ks], sc[qt_][(t_) * 4 + kt], 0, 0, 0); } } while (0)
    __builtin_amdgcn_s_setprio(1);
    if (MODE == 1 || (e00 && e10)) {
#pragma unroll
        for (int ks = 0; ks < NKS; ++ks)
#pragma unroll
            for (int kt = 0; kt < 4; ++kt) { const bf16x8 kf = *(const bf16x8*)(Ks0 + (kt * 16 + l15) * KST + ks * 32 + quad * 8);
                sc[0][kt] = __builtin_amdgcn_mfma_f32_16x16x32_bf16(kf, qf[0][ks], sc[0][kt], 0, 0, 0); sc[1][kt] = __builtin_amdgcn_mfma_f32_16x16x32_bf16(kf, qf[1][ks], sc[1][kt], 0, 0, 0); }
    } else { if (e00) QK_PART(0, 0, Ks0); if (e10) QK_PART(1, 0, Ks0); }
    if (MODE == 1 || (e01 && e11)) {
#pragma unroll
        for (int ks = 0; ks < NKS; ++ks)
#pragma unroll
            for (int kt = 0; kt < 4; ++kt) { const bf16x8 kf = *(const bf16x8*)(Ks1 + (kt * 16 + l15) * KST + ks * 32 + quad * 8);
                sc[0][4 + kt] = __builtin_amdgcn_mfma_f32_16x16x32_bf16(kf, qf[0][ks], sc[0][4 + kt], 0, 0, 0); sc[1][4 + kt] = __builtin_amdgcn_mfma_f32_16x16x32_bf16(kf, qf[1][ks], sc[1][4 + kt], 0, 0, 0); }
    } else { if (e01) QK_PART(0, 1, Ks1); if (e11) QK_PART(1, 1, Ks1); }
    __builtin_amdgcn_s_setprio(0);
#undef QK_PART
    unsigned pb[2][8][2];
#pragma unroll
    for (int qt = 0; qt < 2; ++qt) {
        const bool en0 = qt ? e10 : e00, en1 = qt ? e11 : e01;
        if (MODE == 3 && !(en0 || en1)) continue;
        float bq0 = 0.f, bq1 = 0.f;
        if (MODE == 3) { bq0 = (qt ? b10 : b00) ? c31 : -INFINITY; bq1 = (qt ? b11 : b01) ? c31 : -INFINITY; }
        float mx0 = -INFINITY, mx1 = -INFINITY;
#pragma unroll
        for (int kt = 0; kt < 4; ++kt) { mx0 = fmaxf(fmaxf(mx0, fmaxf(sc[qt][kt][0], sc[qt][kt][1])), fmaxf(sc[qt][kt][2], sc[qt][kt][3]));
                                           mx1 = fmaxf(fmaxf(mx1, fmaxf(sc[qt][4 + kt][0], sc[qt][4 + kt][1])), fmaxf(sc[qt][4 + kt][2], sc[qt][4 + kt][3])); }
        float xm = fmaxf(__builtin_fmaf(mx0, SL, bq0), __builtin_fmaf(mx1, SL, bq1));
        if (MODE == 3) { if (!en0) xm = __builtin_fmaf(mx1, SL, bq1); if (!en1) xm = __builtin_fmaf(mx0, SL, bq0); }
        xm = xrow16_max(xm);
        const float mn = fmaxf(m[qt], xm), ms = (mn == -INFINITY) ? 0.f : mn;
        const float alpha = __builtin_amdgcn_exp2f(m[qt] - ms); m[qt] = mn;
        const float off0 = (MODE == 3 && !en0) ? -INFINITY : bq0 - ms, off1 = (MODE == 3 && !en1) ? -INFINITY : bq1 - ms; float rsum = 0.f;
#pragma unroll
        for (int k8 = 0; k8 < 8; ++k8) { const float off = k8 < 4 ? off0 : off1; const bool en = k8 < 4 ? en0 : en1; float e0 = 0.f, e1 = 0.f, e2 = 0.f, e3 = 0.f;
            if (MODE == 1 || en) { e0 = __builtin_amdgcn_exp2f(__builtin_fmaf(sc[qt][k8][0], SL, off)); e1 = __builtin_amdgcn_exp2f(__builtin_fmaf(sc[qt][k8][1], SL, off));
                                   e2 = __builtin_amdgcn_exp2f(__builtin_fmaf(sc[qt][k8][2], SL, off)); e3 = __builtin_amdgcn_exp2f(__builtin_fmaf(sc[qt][k8][3], SL, off)); }
            rsum += (e0 + e1) + (e2 + e3); pb[qt][k8][0] = pk2(e0, e1); pb[qt][k8][1] = pk2(e2, e3); }
        l[qt] = l[qt] * alpha + rsum;
        if (__builtin_amdgcn_ballot_w64(alpha != 1.0f) != 0ull) {
#pragma unroll
            for (int d = 0; d < 4; ++d) o[qt][d] *= alpha; }
    }
    { unsigned p0[2][4][2], p1[2][4][2];
#pragma unroll
      for (int qt = 0; qt < 2; ++qt)
#pragma unroll
          for (int kt = 0; kt < 4; ++kt) { p0[qt][kt][0] = pb[qt][kt][0]; p0[qt][kt][1] = pb[qt][kt][1]; p1[qt][kt][0] = pb[qt][4 + kt][0]; p1[qt][kt][1] = pb[qt][4 + kt][1]; }
      if (MODE == 1) { pv_tile(Vs0, p0, o, lane); pv_tile(Vs1, p1, o, lane); }
      else { if (e00 || e10) pv_tile_en(Vs0, p0, o, lane, e00, e10); if (e01 || e11) pv_tile_en(Vs1, p1, o, lane, e01, e11); } }
    return true;
}

template <int MODE, bool PRE = false>
__device__ __forceinline__ void flash_core(const AttnP& p, const FCtx& c, char* smem, const u32x4 mwA, const u32x4 mwB, f32x4 (&o)[2][4], float (&linv)[2], const u32x4 (&pre)[4]) {
    constexpr bool NM = (MODE >= 2);
    constexpr int DK = (MODE == 1) ? 96 : 64, KST = DK + 16, VST = 80, KCH = DK / 8, NKC = 64 * KCH, NKI = (NKC + 511) / 512, NKS = DK / 32, KB = (MODE == 1) ? KB96 : KB64;
    int tid_ = threadIdx.x; asm volatile("" : "+v"(tid_)); const int tid = tid_, lane = tid & 63, l15 = lane & 15, quad = lane >> 4, hl = l15 & 3;
    const int b = c.b, hkv = c.hkv, qw0 = c.qw0, hq = NM ? (hkv * 4 + hl) : c.hq;
    const int qr0 = NM ? qw0 + (l15 >> 2) : qw0 + l15, qr1 = NM ? qr0 + 4 : qr0 + 16;
    const int thi = c.qb_hi >> 6; int tlo = 0;
    if (MODE == 2) { int lo = c.qb_lo - 511; if (lo < 0) lo = 0; tlo = lo >> 6; }
    float pre8[8] = {0.f, 0.f, 0.f, 0.f, 0.f, 0.f, 0.f, 0.f};
    if (MODE == 0) { float acc_ = 0.f;
#pragma unroll
        for (int sg = 0; sg < 8; ++sg) { pre8[sg] = acc_; acc_ += p.segtot[(size_t)(b * 8 + sg) * 8 + hq]; } }
    if (MODE == 0) {
        const float cq0 = cum_at(p.cum, pre8, (size_t)b * S, c.qb_lo, hq); int t = (c.qb_lo >> 6) - 1;
        while (t >= 0 && cq0 - cum_at(p.cum, pre8, (size_t)b * S, t * 64 + 63, hq) >= -88.0f) --t;
        tlo = t + 1; }
    const float SL = ((MODE == 1) ? 0.10206207261596577f : 0.125f) * LOG2E;
    const size_t rowb = (size_t)b * S;
    const bf16* kp = (MODE == 2) ? p.kw : p.k; const bf16* vp = (MODE == 2) ? p.vw : p.v;
    bf16x8 qf[2][NKS];
    const int qoff = (MODE == 1) ? hq * 96 : hq * 64;
#pragma unroll
    for (int ks = 0; ks < NKS; ++ks) { qf[0][ks] = *(const bf16x8*)(p.q + (rowb + qr0) * p.ldq + qoff + ks * 32 + quad * 8); qf[1][ks] = *(const bf16x8*)(p.q + (rowb + qr1) * p.ldq + qoff + ks * 32 + quad * 8); }
    float cq[2] = {0.f, 0.f}; float c31 = 0.f;
    if (MODE == 0) { cq[0] = cum_at(p.cum, pre8, rowb, qr0, hq) * LOG2E; cq[1] = cum_at(p.cum, pre8, rowb, qr1, hq) * LOG2E; }
    if (MODE >= 2) c31 = p.relb[31 * 8 + hq] * LOG2E;
    const int koff = (MODE == 1) ? hkv * 128 : hkv * 64;
    const int voff = (MODE == 1) ? hkv * 128 + 64 : koff;
    u32x4 rkA[NKI], rvA, rkB[NKI], rvB; float rcA = 0.f, rcB = 0.f;
#define FL_LOAD(S_, tile_) do { \
        _Pragma("unroll") for (int i = 0; i < NKI; ++i) { int cc = tid + i * 512; if (NKC % 512 != 0) cc = cc < NKC ? cc : cc - 256; const int key = cc / KCH, kc = cc % KCH; const size_t row = rowb + (tile_) * 64 + key; \
            const bf16* src = kp + row * p.ldk + koff + kc * 8; \
            if (MODE == 1) { const bf16* src2 = p.k2 + row * LDW1 + C_KR + (kc - 8) * 8; src = kc >= 8 ? src2 : src; } \
            rk##S_[i] = *(const u32x4*)src; } \
        { const int key = tid >> 3, vc = tid & 7; rv##S_ = *(const u32x4*)(vp + (rowb + (tile_) * 64 + key) * p.ldv + voff + vc * 8); } \
        if (MODE == 0) rc##S_ = cum_at(p.cum, pre8, rowb, (tile_) * 64 + (tid & 63), hq) * LOG2E; } while (0)
#define FL_STORE(S_, buf_) do { bf16* Kw_ = (bf16*)(smem + OFF_RING + (buf_) * KB); bf16* Vw_ = (bf16*)(smem + OFF_RING + 4 * KB + (buf_) * VBUF); \
        _Pragma("unroll") for (int i = 0; i < NKI; ++i) { const int cc = tid + i * 512; if (NKC % 512 == 0 || cc < NKC) { const int key = cc / KCH, kc = cc % KCH; *(u32x4*)(Kw_ + key * KST + kc * 8) = rk##S_[i]; } } \
        { const int key = tid >> 3, vc = tid & 7; *(u32x4*)(Vw_ + key * VST + vc * 8) = rv##S_; } \
        if (MODE == 0 && tid < 64) ((float*)(smem + OFF_CKS))[(buf_) * 64 + tid] = rc##S_; } while (0)
    float m[2] = {-INFINITY, -INFINITY}, l[2] = {0.f, 0.f};
#pragma unroll
    for (int qt = 0; qt < 2; ++qt)
#pragma unroll
        for (int d = 0; d < 4; ++d) o[qt][d] = (f32x4){0.f, 0.f, 0.f, 0.f};
    if constexpr (MODE == 1) {
#define FL_MIN(a_, b_) ((a_) < (b_) ? (a_) : (b_))
    FL_LOAD(A, tlo); FL_LOAD(B, FL_MIN(tlo + 1, thi));
    __syncthreads();
    FL_STORE(A, 0); FL_STORE(B, 1);
    FL_LOAD(A, FL_MIN(tlo + 2, thi)); FL_LOAD(B, FL_MIN(tlo + 3, thi));
    __syncthreads();
    for (int tile = tlo, st = 0; tile <= thi; tile += 2, ++st) {
        const int pb_ = (st & 1) * 2;
        if (tile + 2 <= thi) { FL_STORE(A, 2 - pb_); FL_STORE(B, 3 - pb_); }
        FL_LOAD(A, FL_MIN(tile + 4, thi)); FL_LOAD(B, FL_MIN(tile + 5, thi));
        bool done = false;
        if constexpr (MODE == 1 || MODE == 3) { if (tile + 1 <= thi) done = fl_tile2<MODE>(smem, tile, pb_, qw0, hl, l15, quad, lane, SL, c31, mwA, mwB, qf, m, l, o); }
        if (!done) {
            fl_tile<MODE>(smem, tile, pb_, qw0, qr0, qr1, hl, l15, quad, lane, SL, c31, cq, mwA, mwB, qf, m, l, o);
            if (tile + 1 <= thi) fl_tile<MODE>(smem, tile + 1, pb_ + 1, qw0, qr0, qr1, hl, l15, quad, lane, SL, c31, cq, mwA, mwB, qf, m, l, o); }
        __syncthreads();
    }
#undef FL_MIN
    } else {
#define FL_MIN(a_, b_) ((a_) < (b_) ? (a_) : (b_))
    if constexpr (PRE) { rkA[0] = pre[0]; rvA = pre[1]; rkB[0] = pre[2]; rvB = pre[3]; }
    else { FL_LOAD(A, tlo); FL_LOAD(B, FL_MIN(tlo + 1, thi)); }
    __syncthreads();
    FL_STORE(A, 0);
    FL_LOAD(A, FL_MIN(tlo + 2, thi));
    __syncthreads();
    for (int tile = tlo; tile <= thi; tile += 2) {
        if (tile + 1 <= thi) FL_STORE(B, 1);
        FL_LOAD(B, FL_MIN(tile + 3, thi));
        fl_tile<MODE>(smem, tile, 0, qw0, qr0, qr1, hl, l15, quad, lane, SL, c31, cq, mwA, mwB, qf, m, l, o);
        __syncthreads();
        if (tile + 1 > thi) break;
        if (tile + 2 <= thi) FL_STORE(A, 0);
        FL_LOAD(A, FL_MIN(tile + 4, thi));
        fl_tile<MODE>(smem, tile + 1, 1, qw0, qr0, qr1, hl, l15, quad, lane, SL, c31, cq, mwA, mwB, qf, m, l, o);
        __syncthreads();
    }
#undef FL_MIN
    }
#undef FL_LOAD
#undef FL_STORE
#pragma unroll
    for (int qt = 0; qt < 2; ++qt) { float lt = l[qt]; lt = xrow16_sum(lt); linv[qt] = 1.0f / fmaxf(lt, 1e-30f); }
}

template <int MODE>
__device__ __forceinline__ void flash_item(const AttnP& p, int item, char* smem) {
    int tid_ = threadIdx.x; asm volatile("" : "+v"(tid_)); const int lane = tid_ & 63, w = tid_ >> 6, l15 = lane & 15, quad = lane >> 4;
    FCtx c; const int nqt = S / 256; const int qt_ = nqt - 1 - item / (NB * 8), bh = item % (NB * 8);
    c.b = bh >> 3; c.hq = bh & 7; c.hkv = c.hq; c.qb_lo = qt_ * 256; c.qb_hi = c.qb_lo + 255; c.qw0 = c.qb_lo + w * 32;
    const u32x4 z = {0u, 0u, 0u, 0u}; f32x4 o[2][4]; float linv[2]; const u32x4 nopre[4] = {z, z, z, z};
    flash_core<MODE>(p, c, smem, z, z, o, linv, nopre);
#pragma unroll
    for (int qt = 0; qt < 2; ++qt) { const size_t row = (size_t)c.b * S + c.qw0 + qt * 16 + l15;
#pragma unroll
        for (int d = 0; d < 4; ++d) { const f32x4 v = o[qt][d] * linv[qt]; *(uint2*)(p.out + row * p.ldo + c.hq * 64 + d * 16 + quad * 4) = pk4(v); } }
}

__device__ __forceinline__ void cmp_core(const AttnP& p, const FCtx& c, char* smem, f32x4 (&o)[2][4], u32x4& mwA, u32x4& mwB, u32x4 (&pre)[4]) {
    constexpr int KST = 80, VST = 80;
    float* tb = (float*)(smem + OFF_TB); float* impq = (float*)(smem + OFF_IMP); float* imps = impq + 64 * IMPS; unsigned* selw = (unsigned*)(smem + OFF_SELW);
    int tid_ = threadIdx.x; asm volatile("" : "+v"(tid_)); const int tid = tid_, lane = tid & 63, w = tid >> 6, l15 = lane & 15, quad = lane >> 4, hl = l15 & 3;
    const int qw0 = c.qw0, bg = c.b * 2 + c.hkv, hq = c.hkv * 4 + hl, qr0 = qw0 + (l15 >> 2), qr1 = qr0 + 4;
    const size_t rowb = (size_t)c.b * S;
    const int nk = (c.qb_lo + 32) / 16 + 1, ntile = (nk + 63) >> 6;
    const float SL = 0.125f * LOG2E; const float c31 = p.relb[31 * 8 + hq] * LOG2E;
    bf16x8 qf[2][2];
#pragma unroll
    for (int ks = 0; ks < 2; ++ks) { qf[0][ks] = *(const bf16x8*)(p.q + (rowb + qr0) * p.ldq + hq * 64 + ks * 32 + quad * 8); qf[1][ks] = *(const bf16x8*)(p.q + (rowb + qr1) * p.ldq + hq * 64 + ks * 32 + quad * 8); }
    const bf16* kb = p.kcb + (size_t)bg * 512 * 64; const bf16* vb = p.vcb + (size_t)bg * 512 * 64;
    u32x4 rk, rv;
#define CM_LOAD(tile_) do { const int key = tid >> 3, kc = tid & 7; rk = *(const u32x4*)(kb + (size_t)((tile_) * 64 + key) * 64 + kc * 8); rv = *(const u32x4*)(vb + (size_t)((tile_) * 64 + key) * 64 + kc * 8); } while (0)
#define CM_STORE(buf_) do { const int key = tid >> 3, kc = tid & 7; *(u32x4*)((bf16*)(smem + OFF_RING + (buf_) * KB64) + key * KST + kc * 8) = rk; *(u32x4*)((bf16*)(smem + OFF_RING + 4 * KB64 + (buf_) * VBUF) + key * VST + kc * 8) = rv; } while (0)
#define CM_SCORE(tile_) do { qk_tile<2, KST>(Ks, qf, sc, l15, quad); \
        if (qw0 - (16 * ((tile_) * 64 + 63) + 31) >= 128) {            \
            _Pragma("unroll") for (int qt = 0; qt < 2; ++qt) _Pragma("unroll") for (int kt = 0; kt < 4; ++kt) _Pragma("unroll") for (int r = 0; r < 4; ++r) sc[qt][kt][r] = __builtin_fmaf(sc[qt][kt][r], SL, c31); \
        } else \
        _Pragma("unroll") for (int qt = 0; qt < 2; ++qt) { const int q = qt ? qr1 : qr0; \
            _Pragma("unroll") for (int kt = 0; kt < 4; ++kt) _Pragma("unroll") for (int r = 0; r < 4; ++r) { const int ci = (tile_) * 64 + kt * 16 + quad * 4 + r; const int dd = q - (16 * ci + 31); \
                const int di = dd < 0 ? 0 : (dd > 127 ? 127 : dd); const float tv = tb[hl * 136 + di]; const float bs = dd < 128 ? tv : c31; \
                sc[qt][kt][r] = (dd >= 0) ? __builtin_fmaf(sc[qt][kt][r], SL, bs) : -INFINITY; } } } while (0)
    float m[2] = {-INFINITY, -INFINITY}, l[2] = {0.f, 0.f};
    float ms2[2] = {0.f, 0.f}, il[2] = {0.f, 0.f};
#pragma unroll
    for (int qt = 0; qt < 2; ++qt)
#pragma unroll
        for (int d = 0; d < 4; ++d) o[qt][d] = (f32x4){0.f, 0.f, 0.f, 0.f};
    for (int pass = 0; pass < 2; ++pass) {
        CM_LOAD(0);
        __syncthreads();
        CM_STORE(0);
        if (ntile > 1) CM_LOAD(1);
        __syncthreads();
        for (int tile = 0; tile < ntile; ++tile) {
            const int cur = tile & 1;
            if (tile + 1 < ntile) { CM_STORE(cur ^ 1); if (tile + 2 < ntile) CM_LOAD(tile + 2); }
            if (tile * 64 * 16 + 31 <= qw0 + 7) {
                const bf16* Ks = (const bf16*)(smem + OFF_RING + cur * KB64); const bf16* Vs = (const bf16*)(smem + OFF_RING + 4 * KB64 + cur * VBUF);
                f32x4 sc[2][4]; CM_SCORE(tile);
                if (pass == 0) {
#pragma unroll
                    for (int qt = 0; qt < 2; ++qt) { float mx = -INFINITY;
#pragma unroll
                        for (int kt = 0; kt < 4; ++kt) mx = fmaxf(fmaxf(mx, fmaxf(sc[qt][kt][0], sc[qt][kt][1])), fmaxf(sc[qt][kt][2], sc[qt][kt][3]));
                        mx = xrow16_max(mx);
                        const float mn = fmaxf(m[qt], mx), ms = (mn == -INFINITY) ? 0.f : mn; const float alpha = __builtin_amdgcn_exp2f(m[qt] - ms); m[qt] = mn; float rsum = 0.f;
#pragma unroll
                        for (int kt = 0; kt < 4; ++kt)
#pragma unroll
                            for (int r = 0; r < 4; ++r) rsum += __builtin_amdgcn_exp2f(sc[qt][kt][r] - ms);
                        l[qt] = l[qt] * alpha + rsum; }
                } else {
                    unsigned pb[2][4][2];
#pragma unroll
                    for (int qt = 0; qt < 2; ++qt) { const int ql = w * 8 + qt * 4 + (l15 >> 2);
#pragma unroll
                        for (int kt = 0; kt < 4; ++kt) { const float e0 = __builtin_amdgcn_exp2f(sc[qt][kt][0] - ms2[qt]) * il[qt], e1 = __builtin_amdgcn_exp2f(sc[qt][kt][1] - ms2[qt]) * il[qt],
                                                               e2 = __builtin_amdgcn_exp2f(sc[qt][kt][2] - ms2[qt]) * il[qt], e3 = __builtin_amdgcn_exp2f(sc[qt][kt][3] - ms2[qt]) * il[qt];
                            pb[qt][kt][0] = pk2(e0, e1); pb[qt][kt][1] = pk2(e2, e3);
                            float qs = (e0 + e1) + (e2 + e3), es = e3;
                            qs += dppf<DPP_XOR1>(qs); qs += dppf<DPP_XOR2>(qs); es += dppf<DPP_XOR1>(es); es += dppf<DPP_XOR2>(es);
                            const int j = tile * 16 + kt * 4 + quad;
                            if (hl == 0) { impq[ql * IMPS + j] = qs; if (j + 1 < 128) imps[ql * IMPS + j + 1] = es; } } }
                    pv_tile(Vs, pb, o, lane);
                }
            }
            __syncthreads();
        }
        if (pass == 0) {
#pragma unroll
            for (int qt = 0; qt < 2; ++qt) { const float lt = xrow16_sum(l[qt]); il[qt] = 1.0f / fmaxf(lt, 1e-30f); ms2[qt] = (m[qt] == -INFINITY) ? 0.f : m[qt]; } }
    }
#undef CM_LOAD
#undef CM_STORE
#undef CM_SCORE
    {
        const int key = tid >> 3, kc = tid & 7, t1 = (c.qb_hi >> 6) >= 1 ? 1 : 0;
        pre[0] = *(const u32x4*)(p.k + (rowb + key) * p.ldk + c.hkv * 64 + kc * 8); pre[1] = *(const u32x4*)(p.v + (rowb + key) * p.ldv + c.hkv * 64 + kc * 8);
        pre[2] = *(const u32x4*)(p.k + (rowb + t1 * 64 + key) * p.ldk + c.hkv * 64 + kc * 8); pre[3] = *(const u32x4*)(p.v + (rowb + t1 * 64 + key) * p.ldv + c.hkv * 64 + kc * 8); }
    {
        const int qy = tid >> 3, sub = tid & 7, cur = c.qb_lo >> 6;
        unsigned m0 = 1u, m1 = 0u, m2 = 0u, m3 = 0u;
#define SETBIT(j_) do { const int jj_ = (j_); const unsigned bb_ = 1u << (jj_ & 31); const int wi_ = jj_ >> 5; m0 |= wi_ == 0 ? bb_ : 0u; m1 |= wi_ == 1 ? bb_ : 0u; m2 |= wi_ == 2 ? bb_ : 0u; m3 |= wi_ == 3 ? bb_ : 0u; } while (0)
        if (cur <= 15) { m0 = (1u << (cur + 1)) - 1u; }
        else {
            SETBIT(cur); SETBIT(cur - 1);
            float v[16];
#pragma unroll
            for (int i = 0; i < 16; ++i) { const int j = sub + 8 * i; v[i] = (j >= 1 && j <= cur - 2) ? impq[qy * IMPS + j] + imps[qy * IMPS + j] : -INFINITY; }
            for (int it = 0; it < 13; ++it) { float bv = -INFINITY; int bj = 1 << 20;
#pragma unroll
                for (int i = 0; i < 16; ++i) { if (v[i] > bv) { bv = v[i]; bj = sub + 8 * i; } }
                { const float ov = dppf<DPP_XOR1>(bv); const int oj = dppi<DPP_XOR1>(bj); if (ov > bv || (ov == bv && oj < bj)) { bv = ov; bj = oj; } }
                { const float ov = dppf<DPP_XOR2>(bv); const int oj = dppi<DPP_XOR2>(bj); if (ov > bv || (ov == bv && oj < bj)) { bv = ov; bj = oj; } }
                { const float ov = dppf<DPP_HMIRROR>(bv); const int oj = dppi<DPP_HMIRROR>(bj); if (ov > bv || (ov == bv && oj < bj)) { bv = ov; bj = oj; } }
                SETBIT(bj);
#pragma unroll
                for (int i = 0; i < 16; ++i) v[i] = (sub + 8 * i == bj) ? -INFINITY : v[i]; }
        }
#undef SETBIT
        if (sub == 0) *(u32x4*)(selw + qy * 4) = (u32x4){m0, m1, m2, m3};
    }
    __syncthreads();
    mwA = *(const u32x4*)(selw + (w * 8 + (l15 >> 2)) * 4); mwB = *(const u32x4*)(selw + (w * 8 + 4 + (l15 >> 2)) * 4);
    __syncthreads();
}

__device__ __forceinline__ void nsa_item(const AttnP& p, int item, char* smem) {
    int tid_ = threadIdx.x; asm volatile("" : "+v"(tid_)); const int tid = tid_, lane = tid & 63, w = tid >> 6, l15 = lane & 15, quad = lane >> 4, hl = l15 & 3;
    FCtx c; const int nqt = S / 64; const int qt_ = nqt - 1 - item / (NB * 2), bg = item % (NB * 2);
    c.b = bg >> 1; c.hkv = bg & 1; c.hq = c.hkv * 4; c.qb_lo = qt_ * 64; c.qb_hi = c.qb_lo + 63; c.qw0 = c.qb_lo + 8 * w;
    const int hq = c.hkv * 4 + hl; const size_t row0 = (size_t)c.b * S + c.qw0 + (l15 >> 2), row1 = row0 + 4;
    float* tb = (float*)(smem + OFF_TB); float* ys = (float*)(smem + OFF_Y) + w * 32 * YST;
    tb[(tid >> 7) * 136 + (tid & 127)] = p.tbg[(c.hkv * 4 + (tid >> 7)) * 128 + (tid & 127)];
    u32x4 mwA, mwB; f32x4 o[2][4]; float linv[2]; u32x4 pre[4];
    bf16 glr[2][3]; float bg3[3];
#pragma unroll
    for (int j = 0; j < 3; ++j) { glr[0][j] = p.gl[row0 * LDW1 + C_GL + hq * 3 + j]; glr[1][j] = p.gl[row1 * LDW1 + C_GL + hq * 3 + j]; bg3[j] = p.bgate[hq * 3 + j]; }
    cmp_core(p, c, smem, o, mwA, mwB, pre);
#pragma unroll
    for (int qt = 0; qt < 2; ++qt) { const float g0 = sigmoidf_(bf2f(glr[qt][0]) + bg3[0]);
#pragma unroll
        for (int d = 0; d < 4; ++d) *(f32x4*)(ys + (qt * 16 + l15) * YST + d * 16 + quad * 4) = o[qt][d] * g0; }
    flash_core<3, true>(p, c, smem, mwA, mwB, o, linv, pre);
#pragma unroll
    for (int qt = 0; qt < 2; ++qt) { const float g1 = sigmoidf_(bf2f(glr[qt][1]) + bg3[1]) * linv[qt];
#pragma unroll
        for (int d = 0; d < 4; ++d) { f32x4* yp = (f32x4*)(ys + (qt * 16 + l15) * YST + d * 16 + quad * 4); *yp = *yp + o[qt][d] * g1; } }
    flash_core<2>(p, c, smem, mwA, mwB, o, linv, pre);
#pragma unroll
    for (int qt = 0; qt < 2; ++qt) { const size_t row = qt ? row1 : row0; const float g2 = sigmoidf_(bf2f(glr[qt][2]) + bg3[2]) * linv[qt];
#pragma unroll
        for (int d = 0; d < 4; ++d) { const f32x4 v = *(const f32x4*)(ys + (qt * 16 + l15) * YST + d * 16 + quad * 4) + o[qt][d] * g2; *(uint2*)(p.out + row * p.ldo + hq * 64 + d * 16 + quad * 4) = pk4(v); } }
}

typedef float f32x16 __attribute__((ext_vector_type(16)));
struct S5P { const bf16* u0; const float *lre, *lim, *ldt, *bre, *bim, *cre, *cim, *dsk; float* E; bf16* hg; };
constexpr int S5_L = 128, S5_NC = S / S5_L, S5_XST = 144, S5_SMEM = 8 * 32 * S5_XST * 2;
template <bool PASSB>
__device__ __forceinline__ void s5_item(const S5P& p, int item, char* smem) {
    int tid_ = threadIdx.x; asm volatile("" : "+v"(tid_)); const int tid = tid_, lane = tid & 63, w = tid >> 6, l15 = lane & 15, quad = lane >> 4, p31 = lane & 31, hf = lane >> 5;
    const int wv = item * 8 + w, bg = wv >> 5, pair = wv & 31, b = bg >> 5, g = bg & 31, chunk = pair * 2 + hf;
    bf16* Xs = (bf16*)smem + w * 32 * S5_XST;
    const float dt = __expf(p.ldt[g]);
    float ar[2], ai[2]; bf16x8 bbf[4];
#pragma unroll
    for (int st = 0; st < 2; ++st) { const int sidx = g * 64 + st * 32 + p31; const float lr = p.lre[sidx], li = p.lim[sidx];
        const float mag = __expf(lr * dt); ar[st] = mag * cosf(li * dt); ai[st] = mag * sinf(li * dt);
        const float den = lr * lr + li * li, nr = ar[st] - 1.0f, ni = ai[st]; const float fr = (nr * lr + ni * li) / den, fi = (ni * lr - nr * li) / den;
        const f32x4 b0 = *(const f32x4*)(p.bre + (size_t)sidx * 16 + 8 * hf), b1 = *(const f32x4*)(p.bre + (size_t)sidx * 16 + 8 * hf + 4);
        const f32x4 i0 = *(const f32x4*)(p.bim + (size_t)sidx * 16 + 8 * hf), i1 = *(const f32x4*)(p.bim + (size_t)sidx * 16 + 8 * hf + 4);
        const f32x4 r0 = b0 * fr - i0 * fi, r1 = b1 * fr - i1 * fi, m0 = i0 * fr + b0 * fi, m1 = i1 * fr + b1 * fi;
        const u32x4 tr = {pk2(r0[0], r0[1]), pk2(r0[2], r0[3]), pk2(r1[0], r1[1]), pk2(r1[2], r1[3])}, ti = {pk2(m0[0], m0[1]), pk2(m0[2], m0[3]), pk2(m1[0], m1[1]), pk2(m1[2], m1[3])};
        bbf[2 * st] = __builtin_bit_cast(bf16x8, tr); bbf[2 * st + 1] = __builtin_bit_cast(bf16x8, ti); }
    float sr[2] = {0.f, 0.f}, si[2] = {0.f, 0.f};
    bf16x8 cf[4];
    if (PASSB) {
#pragma unroll
        for (int st = 0; st < 2; ++st) { float pr = ar[st], pi = ai[st];
#pragma unroll
            for (int i = 0; i < 7; ++i) { const float t = pr * pr - pi * pi; pi = 2.f * pr * pi; pr = t; }
            const float* ep = p.E + ((size_t)bg * S5_NC * 64 + st * 32 + p31) * 2; float xr = 0.f, xi = 0.f;
#pragma unroll 8
            for (int cpr = 0; cpr < chunk; ++cpr) { const float2 e = *(const float2*)(ep + (size_t)cpr * 128); const float t = pr * xr - pi * xi + e.x; xi = pr * xi + pi * xr + e.y; xr = t; }
            sr[st] = xr; si[st] = xi; }
#pragma unroll
        for (int ks = 0; ks < 4; ++ks)
#pragma unroll
            for (int j = 0; j < 8; ++j) { const int k = ks * 32 + quad * 8 + j, st = k >> 1; const float v = (k & 1) ? -p.cim[(g * 16 + l15) * 64 + st] : p.cre[(g * 16 + l15) * 64 + st]; cf[ks][j] = (short)f2bf(v); }
    }
    const int arow_half = (p31 >> 2) & 1, arow_r = (p31 & 3) + 4 * (p31 >> 3);
    const bf16* ua = p.u0 + ((size_t)b * S + (size_t)(pair * 2 + arow_half) * S5_L + arow_r) * 512 + g * 16 + 8 * hf;
    const f32x4 dv = *(const f32x4*)(p.dsk + g * 16 + quad * 4);
    bf16x8 af = *(const bf16x8*)ua;
    for (int rd = 0; rd < S5_L / 16; ++rd) {
        const int rdn = rd + 1 < S5_L / 16 ? rd + 1 : rd;
        const bf16x8 afn = *(const bf16x8*)(ua + (size_t)rdn * 16 * 512);
        uint2 uwv[2];
        if (PASSB) {
#pragma unroll
            for (int tile = 0; tile < 2; ++tile) uwv[tile] = *(const uint2*)(p.u0 + ((size_t)b * S + (size_t)(pair * 2 + tile) * S5_L + rd * 16 + l15) * 512 + g * 16 + quad * 4); }
        f32x16 bu[4];
#pragma unroll
        for (int ct = 0; ct < 4; ++ct) { f32x16 z;
#pragma unroll
            for (int i = 0; i < 16; ++i) z[i] = 0.f;
            bu[ct] = __builtin_amdgcn_mfma_f32_32x32x16_bf16(af, bbf[ct], z, 0, 0, 0); }
#pragma unroll
        for (int r = 0; r < 16; ++r)
#pragma unroll
            for (int st = 0; st < 2; ++st) { const float nsr = ar[st] * sr[st] - ai[st] * si[st] + bu[2 * st][r], nsi = ar[st] * si[st] + ai[st] * sr[st] + bu[2 * st + 1][r]; sr[st] = nsr; si[st] = nsi;
                if (PASSB) *(unsigned*)(Xs + (hf * 16 + r) * S5_XST + 2 * (st * 32 + p31)) = pk2(nsr, nsi); }
        if (PASSB) {
            __syncthreads();
#pragma unroll
            for (int tile = 0; tile < 2; ++tile) { f32x4 acc = {0.f, 0.f, 0.f, 0.f};
#pragma unroll
                for (int ks = 0; ks < 4; ++ks) { const bf16x8 xf = *(const bf16x8*)(Xs + (tile * 16 + l15) * S5_XST + ks * 32 + quad * 8); acc = __builtin_amdgcn_mfma_f32_16x16x32_bf16(cf[ks], xf, acc, 0, 0, 0); }
                const size_t row = (size_t)b * S + (size_t)(pair * 2 + tile) * S5_L + rd * 16 + l15; const int ch = g * 16 + quad * 4;
                const uint2 uw = uwv[tile]; const f32x4 uv = {__uint_as_float(uw.x << 16), __uint_as_float(uw.x & 0xffff0000u), __uint_as_float(uw.y << 16), __uint_as_float(uw.y & 0xffff0000u)};
                const f32x4 yv = acc + dv * uv;
                *(uint2*)(p.hg + row * 512 + ch) = make_uint2(pk2(gelu_tanh(yv[0]), gelu_tanh(yv[1])), pk2(gelu_tanh(yv[2]), gelu_tanh(yv[3]))); }
            __syncthreads();
        }
        af = afn;
    }
    if (!PASSB) {
#pragma unroll
        for (int st = 0; st < 2; ++st) *(float2*)(p.E + (((size_t)bg * S5_NC + chunk) * 64 + st * 32 + p31) * 2) = make_float2(sr[st], si[st]); }
}

template <int MODE>
__device__ __forceinline__ const float* cvt_col(const float* W, const float* W2, int n) {
    if (MODE == 1) { const int pn = n >> 8, bj = (n >> 7) & 1, cc = n & 127; return (bj ? W2 : W) + pn * 128 + cc; }
    if (MODE == 2) { const int hh = n / 96, cc = n - hh * 96; if (cc < 64) return W + n; const int r = cc - 64; return W + hh * 96 + 64 + (r & 1) * 16 + (r >> 1); }
    if (MODE == 3) { if (n >= C_KR && n < C_KR + 32) { const int r = n - C_KR; return W + C_KR + (r & 1) * 16 + (r >> 1); } return W + n; }
    if (MODE == 4) return W + (n & 127) + (size_t)(n >> 7) * 1024 * 128;
    return W + n;
}
template <int MODE, bool HASGAIN>
__device__ __forceinline__ void cvt_all(const float* W, const float* W2, int ldw, const float* gain, bf16* dst, int N, int Nsrc, int K, char* smem, int bid, int G) {
    constexpr int TST = 132; bf16* t = (bf16*)smem;
    const int nT = N / 64, nt = nT * (K / 128);
    int tid_ = threadIdx.x; asm volatile("" : "+v"(tid_)); const int tid = tid_, n = tid & 63, kq = tid >> 6;
    float v[16];
#define CV_LOAD(tile_) do { const int tn_ = (tile_) % nT, tk_ = (tile_) / nT, ng_ = tn_ * 64 + n; const bool ok_ = ng_ < Nsrc; const float* col_ = cvt_col<MODE>(W, W2, ok_ ? ng_ : 0); \
        _Pragma("unroll") for (int i = 0; i < 8; ++i) { const int k_ = tk_ * 128 + i * 16 + kq * 2; float a_ = col_[(size_t)k_ * ldw], b_ = col_[(size_t)(k_ + 1) * ldw]; \
            if (HASGAIN) { a_ *= gain[k_]; b_ *= gain[k_ + 1]; } v[2 * i] = ok_ ? a_ : 0.f; v[2 * i + 1] = ok_ ? b_ : 0.f; } } while (0)
    int tile = bid;
    if (tile < nt) CV_LOAD(tile);
    for (; tile < nt; tile += G) {
        const int tn = tile % nT, tk = tile / nT;
        __syncthreads();
#pragma unroll
        for (int i = 0; i < 8; ++i) *(unsigned*)(t + n * TST + i * 16 + kq * 2) = pk2(v[2 * i], v[2 * i + 1]);
        __syncthreads();
        if (tile + G < nt) CV_LOAD(tile + G);
        { const int nn = tid >> 3, kc = tid & 7; const bf16* src = t + nn * TST + kc * 16;
          const u32x2 a0 = *(const u32x2*)src, a1 = *(const u32x2*)(src + 4), a2 = *(const u32x2*)(src + 8), a3 = *(const u32x2*)(src + 12);
          bf16* d = dst + (size_t)(tn * 64 + nn) * K + tk * 128 + kc * 16;
          *(u32x4*)d = (u32x4){a0[0], a0[1], a1[0], a1[1]}; *(u32x4*)(d + 8) = (u32x4){a2[0], a2[1], a3[0], a3[1]}; }
    }
#undef CV_LOAD
    __syncthreads();
}

__device__ __forceinline__ void foxcum_block(const float* flog, const float* bf, float* cum, float* segtot, int item, char* smem) {
    int tid_ = threadIdx.x; asm volatile("" : "+v"(tid_)); const int tid = tid_, lane = tid & 63, w = tid >> 6;
    const int b = item >> 3, seg = item & 7;
    const f32x4 bf0 = *(const f32x4*)bf, bf1 = *(const f32x4*)(bf + 4);
    const size_t r0 = ((size_t)b * S + (size_t)seg * 1024 + (size_t)tid * 2) * 8;
    float a[2][8];
#pragma unroll
    for (int i = 0; i < 2; ++i) { const f32x4 x0 = *(const f32x4*)(flog + r0 + i * 8) + bf0, x1 = *(const f32x4*)(flog + r0 + i * 8 + 4) + bf1;
#pragma unroll
        for (int h = 0; h < 4; ++h) { a[i][h] = log_sigmoid(x0[h]); a[i][4 + h] = log_sigmoid(x1[h]); } }
    double* wt = (double*)smem;
    double run[8];
    __syncthreads();
#pragma unroll
    for (int h = 0; h < 8; ++h) { const double sloc = (double)a[0][h] + (double)a[1][h]; double incl = sloc;
        for (int o = 1; o < 64; o <<= 1) { const double v = __shfl_up(incl, o); if (lane >= o) incl += v; }
        run[h] = incl - sloc; if (lane == 63) wt[w * 8 + h] = incl; }
    __syncthreads();
#pragma unroll
    for (int h = 0; h < 8; ++h) { double pre = 0.0, tot = 0.0; for (int ww = 0; ww < 8; ++ww) { const double v = wt[ww * 8 + h]; pre += ww < w ? v : 0.0; tot += v; } run[h] += pre;
        if (tid == 0) segtot[(size_t)(b * 8 + seg) * 8 + h] = (float)tot; }
#pragma unroll
    for (int i = 0; i < 2; ++i) { f32x4 o0, o1;
#pragma unroll
        for (int h = 0; h < 4; ++h) { run[h] += (double)a[i][h]; run[4 + h] += (double)a[i][4 + h]; o0[h] = (float)run[h]; o1[h] = (float)run[4 + h]; }
        *(f32x4*)(cum + r0 + i * 8) = o0; *(f32x4*)(cum + r0 + i * 8 + 4) = o1; }
}

#define XB_TMO      128
#define XB_XCNT(j)  (256  + 64 * (j))
#define XB_XSUB(j)  (1280 + 64 * (j))
#define XB_XGEN(j)  (2304 + 64 * (j))
#define XB_TOP      3328
#define XB_TOPGEN   3392
#define XCD_BAR_WORDS 3456
#define XB_SPIN_CAP (1u << 22)
__device__ __forceinline__ unsigned xb_ld(unsigned* p)              { return __hip_atomic_load(p, __ATOMIC_RELAXED, __HIP_MEMORY_SCOPE_AGENT); }
__device__ __forceinline__ unsigned xb_add(unsigned* p, unsigned v) { return __hip_atomic_fetch_add(p, v, __ATOMIC_RELAXED, __HIP_MEMORY_SCOPE_AGENT); }
__device__ __forceinline__ unsigned xb_xcc_id() { return (unsigned)__builtin_amdgcn_s_getreg((3 << 11) | 20) & 0xFu; }
#define XB_SPIN(cond, bar) do { unsigned _sp = 0; while (cond) { __builtin_amdgcn_s_sleep(1); \
    if ((++_sp & 255u) == 0u) { if (xb_ld(&(bar)[XB_TMO])) break; if (_sp > XB_SPIN_CAP) { atomicAdd(&(bar)[XB_TMO], 1u); break; } } } } while (0)
struct XcdBarrier { unsigned* bar; unsigned x; volatile LDS_AS unsigned* st; };
__device__ __forceinline__ XcdBarrier xcd_barrier_post(unsigned* bar, volatile LDS_AS unsigned* st) {
    XcdBarrier b; b.bar = bar; b.x = xb_xcc_id(); b.st = st;
    if (threadIdx.x == 0) (void)xb_add(&bar[XB_XCNT(b.x)], 1u);
    return b;
}
__device__ __forceinline__ void xcd_barrier_complete(unsigned* bar, unsigned x, unsigned& nloc, unsigned& nx) {
    const unsigned G = gridDim.x * gridDim.y * gridDim.z;
    unsigned sum, cnt, mine, sp = 0u;
    for (;;) {
        sum = 0u; cnt = 0u; mine = 0u;
#pragma unroll
        for (unsigned j = 0; j < 16; ++j) { const unsigned c = xb_ld(&bar[XB_XCNT(j)]); sum += c; cnt += (c > 0u) ? 1u : 0u; mine = (j == x) ? c : mine; }
        if (sum == G) break;
        __builtin_amdgcn_s_sleep(1);
        if ((++sp & 255u) == 0u) { if (xb_ld(&bar[XB_TMO])) break; if (sp > XB_SPIN_CAP) { atomicAdd(&bar[XB_TMO], 1u); break; } }
    }
    nloc = mine > 0u ? mine : 1u; nx = cnt > 0u ? cnt : 1u;
}
__device__ __forceinline__ void xcd_barrier(const XcdBarrier& b) {
    asm volatile("s_waitcnt vmcnt(0)" ::: "memory");
    __syncthreads();
    if (threadIdx.x == 0) {
        unsigned* bar = b.bar;
        __builtin_amdgcn_s_waitcnt(0);
        unsigned nloc = b.st[0], nx = b.st[1];
        if (nloc == 0u) { xcd_barrier_complete(bar, b.x, nloc, nx); b.st[0] = nloc; b.st[1] = nx; }
        const unsigned old = xb_add(&bar[XB_XSUB(b.x)], 1u);
        const unsigned gen = old / nloc;
        if (old + 1u == (gen + 1u) * nloc) {
            __builtin_amdgcn_fence(__ATOMIC_RELEASE, "agent");
            asm volatile("s_waitcnt vmcnt(0)" ::: "memory");
            const unsigned og = xb_add(&bar[XB_TOP], 1u);
            const unsigned tg = og / nx;
            if (og + 1u == (tg + 1u) * nx) xb_add(&bar[XB_TOPGEN], 1u);
            else XB_SPIN(xb_ld(&bar[XB_TOPGEN]) == tg, bar);
            __builtin_amdgcn_fence(__ATOMIC_ACQUIRE, "agent");
            xb_add(&bar[XB_XGEN(b.x)], 1u);
            asm volatile("s_waitcnt vmcnt(0)" ::: "memory");
        } else {
            XB_SPIN(xb_ld(&bar[XB_XGEN(b.x)]) == gen, bar);
            __builtin_amdgcn_fence(__ATOMIC_ACQUIRE, "agent");
            asm volatile("s_waitcnt vmcnt(0)" ::: "memory");
        }
    }
    __syncthreads();
}

#define GB_BASE     (XCD_BAR_WORDS + 64 * 64)
#define GB_CNT(j)   (GB_BASE + 64 * (j))
#define GB_GEN(j)   (GB_BASE + 512 + 64 * (j))
#define GB_MASK(j)  (GB_BASE + 1024 + 64 * (j))
#define GB_WORDS    1536
#define NSA_Q       (GB_BASE + GB_WORDS)
#define Q_WORDS     64
__device__ __forceinline__ void grp_barrier(const XcdBarrier& b) {
    asm volatile("s_waitcnt vmcnt(0)" ::: "memory");
    __syncthreads();
    if (threadIdx.x == 0) {
        unsigned* bar = b.bar; const unsigned g = blockIdx.x & 7u, G = gridDim.x, gsz = (G - 1u - g) / 8u + 1u;
        __builtin_amdgcn_s_waitcnt(0);
        const unsigned coloc = b.st[2], gen = b.st[3];
        if (!coloc) { __builtin_amdgcn_fence(__ATOMIC_RELEASE, "agent"); asm volatile("s_waitcnt vmcnt(0)" ::: "memory"); }
        const unsigned old = xb_add(&bar[GB_CNT(g)], 1u);
        if (old + 1u == (gen + 1u) * gsz) xb_add(&bar[GB_GEN(g)], 1u);
        else XB_SPIN(xb_ld(&bar[GB_GEN(g)]) == gen, bar);
        __builtin_amdgcn_fence(__ATOMIC_ACQUIRE, "agent");
        asm volatile("s_waitcnt vmcnt(0)" ::: "memory");
        b.st[3] = gen + 1u;
    }
    __syncthreads();
}

struct MegaP { const float* in[47]; WS ws; float* h; };
constexpr int MEGA_SMEM = (FL_SMEM > 131072 ? FL_SMEM : 131072);
#define FOR_ITEMS(it_, n_) for (int r_ = 0, it_ = bid; r_ * G < (n_); ++r_, it_ = r_ * G + ((r_ & 1) ? G - 1 - bid : bid)) if (it_ < (n_))

__device__ __forceinline__ void cvt_ffn(const float* gain, const float* wg, const float* wu, const float* wd, bf16* w1, bf16* w2, char* smem, int bid, int G) {
    cvt_all<1, true>(wg, wu, FF, gain, w1, 2 * FF, 2 * FF, D, smem, bid, G);
    cvt_all<0, false>(wd, nullptr, D, nullptr, w2, D, D, FF, smem, bid, G);
}
__device__ __forceinline__ void ffn_phases(const MegaP& P, const bf16* w1, const bf16* w2, char* smem, int bid, int G, const XcdBarrier& xb, int cvt_base = -1, bf16* cw1 = nullptr, bf16* cw2 = nullptr, const float* hin32 = nullptr, float* hout32 = nullptr, bool full_after = false) {
    const WS& ws = P.ws;
    big_gemm<EpiFFN1, true>(ws.hb, D, w1, T, 2 * FF, D, EpiFFN1{ws.hid, ws.ssq}, smem, G, bid);
    if (cvt_base >= 0 && bid >= G / 2) { __syncthreads(); cvt_ffn(P.in[cvt_base], P.in[cvt_base + 1], P.in[cvt_base + 2], P.in[cvt_base + 3], cw1, cw2, smem, bid - G / 2, G - G / 2); }
    grp_barrier(xb);
    if (hout32) { res_gemm(ws.hid, FF, w2, FF, EpiRes{nullptr, hout32, ws.hb, ws.ssq, P.in[46], ws.bar + XCD_BAR_WORDS, 0.5f, 0}, smem, G, bid); return; }
    res_gemm(ws.hid, FF, w2, FF, EpiRes{hin32, nullptr, ws.hb, ws.ssq, nullptr, nullptr, 0.5f, 0}, smem, G, bid);
    if (full_after) xcd_barrier(xb); else grp_barrier(xb);
}
template <class Epi>
__device__ __forceinline__ void small_gemm_pair(const GemmP& g0, const Epi& e0, const GemmP& g1, const Epi& e1, int it, char* smem) {
    const int half = threadIdx.x >> 8; const int t = (it & 7) * 2 + half; bf16* sm = (bf16*)(smem + half * G_SMEM);
    __syncthreads();
    if (it < 8) gemm_tile<Epi, false>(g0, e0, t, 0, sm); else gemm_tile<Epi, false>(g1, e1, t, 0, sm);
}

__global__ void __launch_bounds__(512) mega_kernel(MegaP P) {
    __shared__ __attribute__((aligned(16))) char smem[MEGA_SMEM + 32];
    cg::grid_group grid = cg::this_grid();
    const WS& ws = P.ws; const float* const* in = P.in;
    const int G = gridDim.x, bid = blockIdx.x, tid = threadIdx.x, lane = tid & 63, w = tid >> 6;
    volatile LDS_AS unsigned* st = (volatile LDS_AS unsigned*)(smem + MEGA_SMEM);
    if (tid == 0) { st[0] = 0u; st[1] = 0u; st[2] = 0u; st[3] = 0u; }
    __syncthreads();
    const XcdBarrier xb = xcd_barrier_post(ws.bar, st);
    if (tid == 0) __hip_atomic_fetch_or(&ws.bar[GB_MASK(bid & 7)], 1u << xb.x, __ATOMIC_RELAXED, __HIP_MEMORY_SCOPE_AGENT);
    cvt_all<1, true>(in[3], in[4], FF, in[2], ws.wA1, 2 * FF, 2 * FF, D, smem, bid, G);
    cvt_all<0, false>(in[5], nullptr, D, nullptr, ws.wA2, D, D, FF, smem, (bid + 64) % G, G);
    cvt_all<0, true>(in[7], nullptr, EVEN_IN, in[6], ws.wt_in0, 2048, 2048, D, smem, bid, G);
    cvt_all<0, false>(in[19], nullptr, D, nullptr, ws.wt_out0, D, D, D, smem, (bid + 224) % G, G);
    cvt_all<0, false>(in[16], nullptr, 512, nullptr, ws.wt_glu, 512, 512, 512, smem, (bid + 96) % G, G);
    for (int oc = bid; oc < 256; oc += G) {
        const int which = oc >> 7, n = oc & 127; const float* pe = which ? in[35] : in[34]; const float* w1 = which ? in[38] : in[36]; float sacc = 0.f;
#pragma unroll
        for (int i = 0; i < 4; ++i) { const int k = tid + i * 512; sacc += pe[k] * w1[(size_t)k * 128 + n]; }
        for (int o = 32; o; o >>= 1) sacc += __shfl_xor(sacc, o);
        float* red = (float*)smem; __syncthreads(); if (lane == 0) red[w] = sacc; __syncthreads();
        if (tid == 0) ws.cb1[oc] = ((red[0] + red[1]) + (red[2] + red[3])) + ((red[4] + red[5]) + (red[6] + red[7])); }
    if (bid == 0 && tid < 128) { const int n = tid; int b_; if (n < 16) b_ = n; else { const float v = logf((float)n / 16.0f) / 2.0794415416798357f * 16.0f; b_ = 16 + (int)v; if (b_ > 31) b_ = 31; } ws.bkt[n] = b_;
#pragma unroll
        for (int hq = 0; hq < 8; ++hq) ws.tbg[hq * 128 + n] = in[1][b_ * 8 + hq] * LOG2E; }
    for (int row0 = bid * 8 + w; row0 < T; row0 += G * 8 * 4) {
        f32x4 xv[4][4];
#pragma unroll
        for (int j = 0; j < 4; ++j) { int row = row0 + j * G * 8; row = row < T ? row : row0;
#pragma unroll
            for (int i = 0; i < 4; ++i) xv[j][i] = *(const f32x4*)(in[0] + (size_t)row * D + i * 256 + lane * 4); }
#pragma unroll
        for (int j = 0; j < 4; ++j) { const int row = row0 + j * G * 8; if (row < T) { float s = 0.f;
#pragma unroll
            for (int i = 0; i < 4; ++i) { const f32x4 v = xv[j][i]; *(uint2*)(ws.hb + (size_t)row * D + i * 256 + lane * 4) = pk4(v); s += v[0] * v[0] + v[1] * v[1] + v[2] * v[2] + v[3] * v[3]; }
            for (int o = 32; o; o >>= 1) s += __shfl_xor(s, o);
            if (lane < 4) ws.ssq[(size_t)row * 4 + lane] = lane == 0 ? s : 0.f; } } }
    xcd_barrier(xb);
    grid.sync();
    if (tid == 0) { const unsigned mk = xb_ld(&ws.bar[GB_MASK(bid & 7)]); st[2] = (__builtin_popcount(mk) == 1) ? 1u : 0u; }
    ffn_phases(P, ws.wA1, ws.wA2, smem, bid, G, xb, 20, ws.wB1, ws.wB2);
    big_gemm<EpiWin0, false>(ws.hb, D, ws.wt_in0, T, 2048, D, EpiWin0{ws.u0, ws.qkv0, ws.ssq}, smem, G, bid);
    {
        __syncthreads();
        constexpr int WST = 1040; bf16* wf = (bf16*)smem;
        for (int k = tid; k < 1024; k += 512) { const f32x4 w0 = *(const f32x4*)(in[7] + (size_t)k * EVEN_IN + 2048), w1 = *(const f32x4*)(in[7] + (size_t)k * EVEN_IN + 2052); const float gk = in[6][k];
#pragma unroll
            for (int j = 0; j < 4; ++j) { wf[j * WST + k] = f2bf(w0[j] * gk); wf[(4 + j) * WST + k] = f2bf(w1[j] * gk); wf[(8 + j) * WST + k] = (bf16)0; wf[(12 + j) * WST + k] = (bf16)0; } }
        __syncthreads();
        if (w < 4) { const int l15 = lane & 15, quad = lane >> 4; const int row0 = ((8 * (bid & 7) + (bid >> 5)) * 256 + ((bid >> 3) & 3) * 64) + w * 16;
            f32x4 acc0 = {0.f, 0.f, 0.f, 0.f}, acc1 = {0.f, 0.f, 0.f, 0.f};
            const bf16* ap = ws.hb + (size_t)(row0 + l15) * D + quad * 8; const bf16* bp = wf + l15 * WST + quad * 8;
#pragma unroll 4
            for (int ks = 0; ks < 32; ks += 2) {
                const bf16x8 a0 = *(const bf16x8*)(ap + ks * 32), a1 = *(const bf16x8*)(ap + ks * 32 + 32);
                const bf16x8 b0 = *(const bf16x8*)(bp + ks * 32), b1 = *(const bf16x8*)(bp + ks * 32 + 32);
                acc0 = __builtin_amdgcn_mfma_f32_16x16x32_bf16(a0, b0, acc0, 0, 0, 0); acc1 = __builtin_amdgcn_mfma_f32_16x16x32_bf16(a1, b1, acc1, 0, 0, 0); }
            const f32x4 acc = acc0 + acc1;
            if (l15 < 8) {
#pragma unroll
                for (int r = 0; r < 4; ++r) { const int row = row0 + quad * 4 + r; ws.flog[(size_t)row * 8 + l15] = acc[r] * rstd4(ws.ssq, row); } }
        }
    }
    grp_barrier(xb);
    const S5P sp{ws.u0, in[8], in[9], in[10], in[11], in[12], in[13], in[14], in[15], ws.s5e, ws.hg};
    const int ogx = bid & 7, ogj = bid >> 3;
    const int s5it = (((ogx >> 2) * 32 + ogj) << 2) + (ogx & 3);
    if (ogj < 2) { foxcum_block(ws.flog, in[18], ws.cum, ws.segtot, (ogx >> 2) * 8 + (ogx & 3) * 2 + ogj, smem); __syncthreads(); }
    s5_item<false>(sp, s5it, smem);
    xcd_barrier(xb);
    { AttnP a{}; a.q = ws.qkv0; a.ldq = 1536; a.k = ws.qkv0 + 512; a.ldk = 1536; a.v = ws.qkv0 + 1024; a.ldv = 1536; a.cum = ws.cum; a.segtot = ws.segtot; a.out = ws.ycat + 512; a.ldo = D;
      const int fp = 8 * ogx + (ogj & 7), fi = (31 - (fp & 31)) * 16 + (fp >> 5) * 8 + (ogj >> 3);
      __syncthreads(); flash_item<0>(a, fi, smem);
      __syncthreads(); flash_item<0>(a, fi + 4, smem);
      __syncthreads(); s5_item<true>(sp, s5it, smem); }
    grp_barrier(xb);
    big_gemm<EpiGlu, false>(ws.hg, 512, ws.wt_glu, T, 512, 512, EpiGlu{ws.hg, in[17], ws.ycat}, smem, G, bid);
    if (bid >= G / 2) {
        const int vb = bid - G / 2, VG = G - G / 2;
        __syncthreads();
        cvt_all<3, true>(in[29], nullptr, ODD_IN, in[28], ws.wt_in1, 2048, ODD_IN, D, smem, vb, VG);
        cvt_all<2, true>(in[31], nullptr, 768, in[30], ws.wt_uq, 768, 768, 384, smem, vb, VG);
        cvt_all<4, false>(in[36], nullptr, 128, nullptr, ws.wt_c1k, 256, 256, 1024, smem, vb, VG);
        cvt_all<4, false>(in[38], nullptr, 128, nullptr, ws.wt_c1v, 256, 256, 1024, smem, vb, VG);
        cvt_all<0, true>(in[33], nullptr, 1024, in[32], ws.wt_ukv, 1024, 1024, 256, smem, vb, VG);
        cvt_all<0, false>(in[41], nullptr, D, nullptr, ws.wt_out1, D, D, D, smem, vb, VG);
        for (int i = vb * 512 + tid; i < S * 16; i += VG * 512) { const int pos = i >> 4, k = i & 15; const float fr = powf(10000.0f, -(float)k / 16.0f), ang = (float)pos * fr; ws.ropet[2 * i] = cosf(ang); ws.ropet[2 * i + 1] = sinf(ang); }
    }
    grp_barrier(xb);
    res_gemm(ws.ycat, D, ws.wt_out0, D, EpiRes{nullptr, nullptr, ws.hb, ws.ssq, nullptr, nullptr, 1.0f, 0}, smem, G, bid);
    grp_barrier(xb);
    ffn_phases(P, ws.wB1, ws.wB2, smem, bid, G, xb, 24, ws.wA1, ws.wA2, nullptr, nullptr, true);
    ffn_phases(P, ws.wA1, ws.wA2, smem, bid, G, xb, 42, ws.wB1, ws.wB2);
    big_gemm<EpiWin1, false>(ws.hb, D, ws.wt_in1, T, 2048, D, EpiWin1{ws.w1o, ws.ssq, ws.ssq1, ws.ropet, ws.hkv}, smem, G, bid);
    xcd_barrier(xb);
    {
        big_gemm<EpiPQ, false>(ws.hkv, 1024, ws.wt_c1k, 2048, 256, 1024, EpiPQ{ws.pq}, smem, G, bid);
        big_gemm<EpiPQ, false>(ws.hkv + (size_t)2048 * 1024, 1024, ws.wt_c1v, 2048, 256, 1024, EpiPQ{ws.pq + (size_t)2048 * 256}, smem, G, (bid + G - 8) % G);
        big_gemm<EpiUq, false>(ws.w1o + C_CQ, LDW1, ws.wt_uq, T, 768, 384, EpiUq{ws.qmla, ws.ssq1, ws.ropet}, smem, G, (bid + G - 16) % G);
        if (bid >= 16) big_gemm<EpiUkv, false>(ws.w1o + C_CKV, LDW1, ws.wt_ukv, T, 1024, 256, EpiUkv{ws.kvmla, ws.ssq1}, smem, G - 16, bid >= 208 ? bid - 208 : bid + 32);
    }
    xcd_barrier(xb);
    {   GemmP gk{}; gk.amode = 2; gk.PQ = ws.pq; gk.cb1 = ws.cb1; gk.lda = 128; gk.W = in[37]; gk.ldw = 64; gk.M = 2048; gk.N = 64; gk.K = 128;
        GemmP gv = gk; gv.PQ = ws.pq + (size_t)2048 * 256; gv.cb1 = ws.cb1 + 128; gv.W = in[39];
        const GemmP gq = (bid >> 7) ? gv : gk; bf16* outb = (bid >> 7) ? ws.vcb : ws.kcb; const int r0 = (bid & 127) * 16;
        constexpr int WS2 = 144; bf16* wl = (bf16*)smem;
        __syncthreads();
        for (int e = tid; e < 128 * 16; e += 512) { const int k = e >> 4, n4 = (e & 15) * 4; const f32x4 wv = *(const f32x4*)(gq.W + (size_t)k * 64 + n4);
#pragma unroll
            for (int i = 0; i < 4; ++i) wl[(n4 + i) * WS2 + k] = f2bf(wv[i]); }
        __syncthreads();
        if (w == 0) { const int l15 = lane & 15, quad = lane >> 4, m = r0 + l15; const bool ok = a_valid(gq, m);
            f32x4 acc[4];
#pragma unroll
            for (int nt = 0; nt < 4; ++nt) acc[nt] = (f32x4){0.f, 0.f, 0.f, 0.f};
#pragma unroll
            for (int ks = 0; ks < 4; ++ks) { const uint4 av = a_load8(gq, ok ? m : r0, ks * 32 + quad * 8); const u32x4 a4 = {ok ? av.x : 0u, ok ? av.y : 0u, ok ? av.z : 0u, ok ? av.w : 0u}; const bf16x8 af = __builtin_bit_cast(bf16x8, a4);
#pragma unroll
                for (int nt = 0; nt < 4; ++nt) { const bf16x8 wf = *(const bf16x8*)(wl + (nt * 16 + l15) * WS2 + ks * 32 + quad * 8); acc[nt] = __builtin_amdgcn_mfma_f32_16x16x32_bf16(wf, af, acc[nt], 0, 0, 0); } }
#pragma unroll
            for (int nt = 0; nt < 4; ++nt) *(uint2*)(outb + (size_t)m * 64 + nt * 16 + quad * 4) = pk4(acc[nt]); }
    }
    xcd_barrier(xb);
    { AttnP a{}; a.q = ws.qmla; a.ldq = 768; a.k = ws.kvmla; a.ldk = 1024; a.v = ws.kvmla; a.ldv = 1024; a.k2 = ws.w1o; a.out = ws.ycat; a.ldo = D;
      AttnP n{}; n.q = ws.w1o + C_QN; n.ldq = LDW1; n.k = ws.w1o + C_KS; n.ldk = LDW1; n.v = ws.w1o + C_VS; n.ldv = LDW1; n.kw = ws.w1o + C_KW; n.vw = ws.w1o + C_VW;
      n.relb = in[1]; n.bkt = ws.bkt; n.tbg = ws.tbg; n.gl = ws.w1o; n.bgate = in[40]; n.kcb = ws.kcb; n.vcb = ws.vcb; n.out = ws.ycat + 512; n.ldo = D;
      for (;;) { __syncthreads();
          if (tid == 0) st[4] = xb_add(&ws.bar[NSA_Q], 1u);
          __syncthreads();
          const int it = (int)st[4];
          if (it >= 1024) break;
          if (it < 512) flash_item<1>(a, it, smem); else nsa_item(n, it - 512, smem); } }
    xcd_barrier(xb);
    res_gemm(ws.ycat, D, ws.wt_out1, D, EpiRes{nullptr, nullptr, ws.hb, ws.ssq, nullptr, nullptr, 1.0f, 0}, smem, G, bid);
    grp_barrier(xb);
    ffn_phases(P, ws.wB1, ws.wB2, smem, bid, G, xb, -1, nullptr, nullptr, nullptr, P.h);
}

static inline size_t al(size_t x) { return (x + 255) & ~(size_t)255; }
extern "C" void kernel_launch(void* const* d_in, const int* in_sizes, int n_in, void* d_out, int out_size, void* d_ws, size_t ws_size, hipStream_t stream) {
    MegaP P{};
    for (int i = 0; i < 47; ++i) P.in[i] = (const float*)d_in[i];
    P.h = (float*)d_out;
    char* w = (char*)d_ws; size_t off = 0; WS& ws = P.ws;
    auto take = [&](size_t bytes) { char* p = w + off; off += al(bytes); return p; };
    ws.bar = (unsigned*)take((size_t)(XCD_BAR_WORDS + 64 * 64 + GB_WORDS + Q_WORDS) * 4);
    ws.hb = (bf16*)take((size_t)T * D * 2);
    ws.ssq = (float*)take((size_t)T * 32 * 4);
    ws.ssq1 = (float*)take((size_t)T * 32 * 4);
    ws.flog = (float*)take((size_t)T * 8 * 4);
    ws.cum = (float*)take((size_t)T * 8 * 4);
    ws.segtot = (float*)take((size_t)NB * 8 * 8 * 4);
    ws.kcb = (bf16*)take((size_t)4 * 512 * 64 * 2);
    ws.vcb = (bf16*)take((size_t)4 * 512 * 64 * 2);
    ws.s5e = (float*)take((size_t)64 * S5_NC * 64 * 2 * 4);
    ws.cb1 = (float*)take(256 * 4);
    ws.bkt = (int*)take(128 * 4);
    ws.tbg = (float*)take(8 * 128 * 4);
    ws.ropet = (float*)take((size_t)S * 16 * 2 * 4);
    ws.wA1 = (bf16*)take((size_t)2 * FF * D * 2); ws.wA2 = (bf16*)take((size_t)D * FF * 2);
    ws.wB1 = (bf16*)take((size_t)2 * FF * D * 2); ws.wB2 = (bf16*)take((size_t)D * FF * 2);
    ws.wt_in0 = (bf16*)take((size_t)2048 * D * 2); ws.wt_out0 = (bf16*)take((size_t)D * D * 2); ws.wt_glu = (bf16*)take((size_t)512 * 512 * 2);
    ws.wt_in1 = (bf16*)take((size_t)2048 * D * 2); ws.wt_uq = (bf16*)take((size_t)768 * 384 * 2); ws.wt_ukv = (bf16*)take((size_t)1024 * 256 * 2); ws.wt_out1 = (bf16*)take((size_t)D * D * 2);
    ws.wt_c1k = (bf16*)take((size_t)256 * 1024 * 2); ws.wt_c1v = (bf16*)take((size_t)256 * 1024 * 2);
    ws.ycat = (bf16*)take((size_t)T * D * 2);
    ws.hkv = ws.ycat; ws.pq = (float*)((char*)ws.ycat + (size_t)2 * 2048 * 1024 * 2);
    const size_t r0 = off;
    ws.hid = (bf16*)(w + r0);
    ws.u0 = (bf16*)(w + r0); ws.qkv0 = (bf16*)(w + r0 + al((size_t)T * 512 * 2));
    ws.w1o = (bf16*)(w + r0); ws.qmla = (bf16*)(w + r0 + al((size_t)T * LDW1 * 2));
    off = r0 + al((size_t)T * FF * 2);
    ws.hg = (bf16*)(w + off); ws.kvmla = (bf16*)(w + off);
    off += al((size_t)T * 1024 * 2);
    if (off > ws_size) fprintf(stderr, "workspace too small: need %zu have %zu\n", off, ws_size);
    static int grid_blocks = 0;
    if (!grid_blocks) { int dev = 0, cus = 0, per_cu = 0; (void)hipGetDevice(&dev); (void)hipDeviceGetAttribute(&cus, hipDeviceAttributeMultiprocessorCount, dev);
        (void)hipOccupancyMaxActiveBlocksPerMultiprocessor(&per_cu, mega_kernel, 512, 0); if (per_cu < 1) per_cu = 1; grid_blocks = cus; }
    (void)hipMemsetAsync(ws.bar, 0, (size_t)(XCD_BAR_WORDS + 64 * 64 + GB_WORDS + Q_WORDS) * 4, stream);
    void* args[] = {&P};
    hipError_t e = hipLaunchCooperativeKernel((void*)mega_kernel, dim3(grid_blocks), dim3(512), args, 0, stream);
    if (e != hipSuccess) fprintf(stderr, "cooperative launch failed: %s (grid %d)\n", hipGetErrorString(e), grid_blocks);
}
```

```cpp
#include <hip/hip_runtime.h>
#include <hip/hip_cooperative_groups.h>
#include <cstdio>
#include <stdint.h>
namespace cg = cooperative_groups;

typedef unsigned short bf16;
typedef float f32x4 __attribute__((ext_vector_type(4)));
typedef short bf16x8 __attribute__((ext_vector_type(8)));
typedef unsigned u32x4 __attribute__((ext_vector_type(4)));
typedef unsigned u32x2 __attribute__((ext_vector_type(2)));
typedef short s16x4 __attribute__((ext_vector_type(4)));
#define LDS_AS __attribute__((address_space(3)))

constexpr int NB = 2, S = 8192, T = NB * S, D = 1024, FF = 2816;
constexpr int EVEN_IN = 2056, ODD_IN = 1976, LDW1 = 1984;
constexpr int C_CQ = 0, C_CKV = 384, C_KR = 640, C_QN = 672, C_KC = 1184, C_VC = 1312, C_KS = 1440, C_VS = 1568, C_KW = 1696, C_VW = 1824, C_GL = 1952;
constexpr float LOG2E = 1.4426950408889634f;

typedef __bf16 nbf2 __attribute__((ext_vector_type(2)));
typedef float f32x2 __attribute__((ext_vector_type(2)));
__device__ __forceinline__ unsigned pk2(float a, float b) { const f32x2 v = {a, b}; return __builtin_bit_cast(unsigned, __builtin_convertvector(v, nbf2)); }
__device__ __forceinline__ bf16 f2bf(float f) { return (bf16)(pk2(f, 0.f) & 0xffffu); }
__device__ __forceinline__ float bf2f(bf16 h) { return __uint_as_float(((unsigned)h) << 16); }
__device__ __forceinline__ float sigmoidf_(float x) { return __builtin_amdgcn_rcpf(1.0f + __expf(-x)); }
__device__ __forceinline__ float gelu_tanh(float x) { float u = 0.7978845608028654f * (x + 0.044715f * x * x * x); return 0.5f * x * (1.0f + tanhf(u)); }
__device__ __forceinline__ float log_sigmoid(float x) { return fminf(x, 0.f) - __logf(1.0f + __expf(-fabsf(x))); }
__device__ __forceinline__ float xrow16_max(float x) {
    auto s_ = __builtin_amdgcn_permlane16_swap(__float_as_uint(x), __float_as_uint(x), false, false);
    x = fmaxf(__uint_as_float(s_[0]), __uint_as_float(s_[1]));
    auto t_ = __builtin_amdgcn_permlane32_swap(__float_as_uint(x), __float_as_uint(x), false, false);
    return fmaxf(__uint_as_float(t_[0]), __uint_as_float(t_[1]));
}
__device__ __forceinline__ float xrow16_sum(float x) {
    auto s_ = __builtin_amdgcn_permlane16_swap(__float_as_uint(x), __float_as_uint(x), false, false);
    x = __uint_as_float(s_[0]) + __uint_as_float(s_[1]);
    auto t_ = __builtin_amdgcn_permlane32_swap(__float_as_uint(x), __float_as_uint(x), false, false);
    return __uint_as_float(t_[0]) + __uint_as_float(t_[1]);
}
__device__ __forceinline__ uint2 pk4(f32x4 v) { return make_uint2(pk2(v[0], v[1]), pk2(v[2], v[3])); }

namespace pg8 {
#define PG8_LAS __attribute__((address_space(3)))
typedef unsigned short bf16_t;
typedef short bf16x8 __attribute__((ext_vector_type(8)));
typedef float f32x4 __attribute__((ext_vector_type(4)));
typedef unsigned u32x4 __attribute__((ext_vector_type(4)));
constexpr int BM = 256, BK = 64, HALF = 128, HTB = HALF * BK * 2  , STAGE_BYTES = 8 * HTB, NXCD = 8, WGM = 8;

__host__ __device__ __forceinline__ int lds_byte(int r, int c) { const int st = (r >> 4) * 2 + (c >> 5), rr = r & 15, cc = c & 31, ob = rr * 64 + cc * 2; return st * 1024 + (ob ^ (((ob >> 9) & 1) << 5)); }
__host__ __device__ __forceinline__ void stage_rc(int b, int& R, int& C) { const int st = b / 1024, sb = b % 1024, swz = sb ^ (((sb >> 9) & 1) << 5); R = (st >> 1) * 16 + swz / 64; C = (st & 1) * 32 + (swz % 64) / 2; }
__host__ __device__ __forceinline__ int perm32(int rho) { const int n = rho >> 4, i = rho & 15; return 8 * (i >> 2) + 4 * n + (i & 3); }

struct Unit { int pm, pn; };
struct Gemm { const bf16_t* A; const bf16_t* Bt; int M, N, K, lda; };

struct StaticOrder {
    int nM, nN, nwg, G, c;
    __host__ __device__ void init(int M, int N, int G_, int c_) { nM = M / BM; nN = N / BM; nwg = nM * nN; G = G_; c = c_; }
    __host__ __device__ bool next(int i, Unit& u) const {
        const long L = (long)i * G + c; if (L >= nwg) return false;
        int wgid = (int)L; { const int q = nwg / NXCD, r = nwg % NXCD, xcd = wgid % NXCD, off = wgid / NXCD; wgid = (xcd < r ? xcd * (q + 1) : r * (q + 1) + (xcd - r) * q) + off; }
        const int nig = WGM * nN, gid = wgid / nig, fm = gid * WGM, gsz = (nM - fm) < WGM ? (nM - fm) : WGM;
        u.pm = fm + ((wgid % nig) % gsz); u.pn = (wgid % nig) / gsz; return true;
    }
    __device__ __forceinline__ void a_ready(const Unit&) const {}
    __device__ __forceinline__ void done(const Unit&) const {}
};
__device__ __forceinline__ unsigned cvt_pk_bf16(float lo, float hi) { unsigned r; asm volatile("v_cvt_pk_bf16_f32 %0, %1, %2" : "=v"(r) : "v"(lo), "v"(hi)); return r; }
template <class Epi, class Sched, bool ALIGN_EPI = false, bool SP2 = false>
__device__ __forceinline__ void gemm_phase(PG8_LAS unsigned char* lds, const Gemm g, const Sched& S, const Epi& E) {
    int tid_ = threadIdx.x; asm volatile("" : "+v"(tid_));
    const int tid = tid_, wid = __builtin_amdgcn_readfirstlane(tid >> 6), lane = tid & 63, wr = wid >> 2, wc = wid & 3, fr = lane & 15, fq = lane >> 4;
    const int K = g.K, nt = K / BK;
    unsigned voffA[2], voffB[2];
#pragma unroll
    for (int i = 0; i < 2; ++i) { int R, C; stage_rc(tid * 16 + i * 8192, R, C); const int Rb = Epi::PERM ? ((R & ~31) + perm32(R & 31)) : R;
        voffA[i] = (unsigned)(R * g.lda + C) * 2u; voffB[i] = (unsigned)(Rb * K + C) * 2u; }
    const size_t kstep = (size_t)(BK * 2);
    const size_t hstep = (size_t)HALF * K * 2;
    const size_t tstep = 2 * hstep;
    const size_t hstepA = (size_t)HALF * g.lda * 2, tstepA = 2 * hstepA;
    const unsigned ldsw = (unsigned)wid * 1024u;
    const int aoff = lds_byte(wr * 64 + fr, fq * 8), boff = lds_byte(wc * 32 + fr, fq * 8);
    PG8_LAS unsigned char* ldsb = lds + 4 * HTB + boff; asm volatile("" : "+v"(ldsb));
#define PG8_SA(b, h) (((b) * 2 + (h)) * HTB)
#define PG8_SB(b, h) ((4 + (b) * 2 + (h)) * HTB)
#define PG8_STAGE(bufoff, gbase, voff) do { _Pragma("unroll") for (int _i = 0; _i < 2; ++_i) \
        __builtin_amdgcn_global_load_lds((const unsigned*)((const char*)(gbase) + (voff)[_i]), (PG8_LAS unsigned*)(lds + (bufoff) + ldsw + _i * 8192), 16, 0, 0); } while (0)
#define PG8_LDA(dst, b, h) do { _Pragma("unroll") for (int m = 0; m < 4; ++m) _Pragma("unroll") for (int k = 0; k < 2; ++k) dst[m][k] = *(const PG8_LAS bf16x8*)(lds + PG8_SA(b, h) + aoff + m * 2048 + k * 1024); } while (0)
#define PG8_LDB(dst, b, h) do { _Pragma("unroll") for (int n = 0; n < 2; ++n) _Pragma("unroll") for (int k = 0; k < 2; ++k) dst[n][k] = *(const PG8_LAS bf16x8*)(ldsb + ((b) * 2 + (h)) * HTB + n * 2048 + k * 1024); } while (0)
#define PG8_MMA(ai, bj, At, Bt) do { __builtin_amdgcn_s_setprio(1); _Pragma("unroll") for (int m = 0; m < 4; ++m) _Pragma("unroll") for (int n = 0; n < 2; ++n) _Pragma("unroll") for (int k = 0; k < 2; ++k) \
        acc[ai][bj][m][n] = __builtin_amdgcn_mfma_f32_16x16x32_bf16(Bt[n][k], At[m][k], acc[ai][bj][m][n], 0, 0, 0); __builtin_amdgcn_s_setprio(0); } while (0)
#define PG8_WAIT_V(n) asm volatile("s_waitcnt vmcnt(" #n ")" ::: "memory")
#define PG8_WAIT_L(n) asm volatile("s_waitcnt lgkmcnt(" #n ")" ::: "memory")
#define PG8_BAR __builtin_amdgcn_s_barrier()
#define PG8_SCHED __builtin_amdgcn_sched_barrier(0)
    Unit cur, nxt; int ui = 0;
    if (!S.next(0, cur)) return;
    f32x4 acc[2][2][4][2];
#pragma unroll
    for (int a = 0; a < 2; ++a)
#pragma unroll
        for (int b = 0; b < 2; ++b)
#pragma unroll
            for (int m = 0; m < 4; ++m)
#pragma unroll
                for (int n = 0; n < 2; ++n) acc[a][b][m][n] = (f32x4){0.f, 0.f, 0.f, 0.f};
    bf16x8 At[4][2], B0[2][2], B1[2][2];
    const char* cA = (const char*)g.A + (size_t)cur.pm * tstepA; const char* cB = (const char*)g.Bt + (size_t)cur.pn * tstep;
    S.a_ready(cur);
    if constexpr (SP2) {
        PG8_STAGE(PG8_SB(0, 0), cB, voffB); PG8_STAGE(PG8_SB(0, 1), cB + hstep, voffB); PG8_STAGE(PG8_SA(0, 0), cA, voffA); PG8_STAGE(PG8_SA(0, 1), cA + hstepA, voffA);
        if (wr == 1) PG8_BAR;
        PG8_WAIT_V(2); PG8_BAR;
        PG8_STAGE(PG8_SB(1, 0), cB + kstep, voffB); PG8_STAGE(PG8_SA(1, 0), cA + kstep, voffA); PG8_STAGE(PG8_SB(1, 1), cB + hstep + kstep, voffB);
        PG8_WAIT_V(6); PG8_BAR;
    } else {
        PG8_STAGE(PG8_SB(0, 0), cB, voffB); PG8_STAGE(PG8_SA(0, 0), cA, voffA); PG8_STAGE(PG8_SB(0, 1), cB + hstep, voffB); PG8_STAGE(PG8_SA(0, 1), cA + hstepA, voffA);
        if (wr == 1) PG8_BAR;
        PG8_WAIT_V(4); PG8_BAR;
        PG8_STAGE(PG8_SB(1, 0), cB + kstep, voffB); PG8_STAGE(PG8_SA(1, 0), cA + kstep, voffA); PG8_STAGE(PG8_SB(1, 1), cB + hstep + kstep, voffB);
        PG8_WAIT_V(6); PG8_BAR;
    }
    for (;;) {
        const bool has_next = S.next(ui + 1, nxt);
        const char* nA = has_next ? (const char*)g.A + (size_t)nxt.pm * tstepA : cA; const char* nB = has_next ? (const char*)g.Bt + (size_t)nxt.pn * tstep : cB;
        for (int t = 0; t < nt; t += 2) {
            const bool last = (t == nt - 2);
            const char* a1 = cA + (size_t)(t + 1) * kstep;
            const char* a2 = last ? nA : cA + (size_t)(t + 2) * kstep; const char* b2 = last ? nB : cB + (size_t)(t + 2) * kstep;
            const char* a3 = a2 + kstep; const char* b3 = b2 + kstep;
            if (last && has_next) S.a_ready(nxt);
            if constexpr (Epi::RSDMA) {
                if (last) {
                    const char* rsrc = (const char*)(E.rs_src() + (size_t)cur.pm * 1024 + wid * 128);
                    const unsigned rvo = (unsigned)lane * 4u;
                    __builtin_amdgcn_global_load_lds((const unsigned*)(rsrc + rvo), (PG8_LAS unsigned*)(lds + STAGE_BYTES + wid * 512), 4, 0, 0);
                    __builtin_amdgcn_global_load_lds((const unsigned*)(rsrc + 256 + rvo), (PG8_LAS unsigned*)(lds + STAGE_BYTES + wid * 512 + 256), 4, 0, 0); } }
            if constexpr (SP2) {
            PG8_LDB(B0, 0, 0); PG8_LDB(B1, 0, 1); PG8_SCHED; PG8_LDA(At, 0, 0); PG8_STAGE(PG8_SA(1, 1), a1 + hstepA, voffA);
            PG8_WAIT_V(8); PG8_WAIT_L(0); PG8_BAR; PG8_MMA(0, 0, At, B0); PG8_MMA(0, 1, At, B1); PG8_BAR; PG8_SCHED;
            PG8_LDA(At, 0, 1); PG8_STAGE(PG8_SB(0, 0), b2, voffB); PG8_STAGE(PG8_SB(0, 1), b2 + hstep, voffB); PG8_STAGE(PG8_SA(0, 0), a2, voffA);
            PG8_WAIT_V(8); PG8_WAIT_L(0); PG8_BAR; PG8_MMA(1, 0, At, B0); PG8_MMA(1, 1, At, B1); PG8_BAR; PG8_SCHED;
            PG8_LDB(B0, 1, 0); PG8_LDB(B1, 1, 1); PG8_SCHED; PG8_LDA(At, 1, 0); PG8_STAGE(PG8_SA(0, 1), a2 + hstepA, voffA);
            PG8_WAIT_V(8); PG8_WAIT_L(0); PG8_BAR; PG8_MMA(0, 0, At, B0); PG8_MMA(0, 1, At, B1); PG8_BAR; PG8_SCHED;
            PG8_LDA(At, 1, 1); PG8_STAGE(PG8_SB(1, 0), b3, voffB); PG8_STAGE(PG8_SB(1, 1), b3 + hstep, voffB); PG8_STAGE(PG8_SA(1, 0), a3, voffA);
            PG8_WAIT_V(8); PG8_WAIT_L(0); PG8_BAR; PG8_MMA(1, 0, At, B0); PG8_MMA(1, 1, At, B1); PG8_BAR; PG8_SCHED;
            } else {
            PG8_LDB(B0, 0, 0); PG8_SCHED; PG8_LDA(At, 0, 0); PG8_STAGE(PG8_SA(1, 1), a1 + hstepA, voffA);
            PG8_WAIT_L(8); PG8_BAR; PG8_WAIT_L(0); PG8_MMA(0, 0, At, B0); PG8_BAR; PG8_SCHED;
            PG8_LDB(B1, 0, 1); PG8_STAGE(PG8_SB(0, 0), b2, voffB);
            PG8_BAR; PG8_WAIT_L(0); PG8_MMA(0, 1, At, B1); PG8_BAR;
            PG8_LDA(At, 0, 1); PG8_STAGE(PG8_SA(0, 0), a2, voffA);
            PG8_BAR; PG8_WAIT_L(0); PG8_MMA(1, 0, At, B0); PG8_BAR; PG8_SCHED;
            PG8_STAGE(PG8_SB(0, 1), b2 + hstep, voffB);
            PG8_WAIT_V(6); PG8_BAR; PG8_MMA(1, 1, At, B1); PG8_BAR;
            PG8_LDB(B0, 1, 0); PG8_SCHED; PG8_LDA(At, 1, 0); PG8_STAGE(PG8_SA(0, 1), a2 + hstepA, voffA);
            PG8_WAIT_L(8); PG8_BAR; PG8_WAIT_L(0); PG8_MMA(0, 0, At, B0); PG8_BAR; PG8_SCHED;
            PG8_LDB(B1, 1, 1); PG8_STAGE(PG8_SB(1, 0), b3, voffB);
            PG8_BAR; PG8_WAIT_L(0); PG8_MMA(0, 1, At, B1); PG8_BAR;
            PG8_LDA(At, 1, 1); PG8_STAGE(PG8_SA(1, 0), a3, voffA);
            PG8_BAR; PG8_WAIT_L(0); PG8_MMA(1, 0, At, B0); PG8_BAR; PG8_SCHED;
            PG8_STAGE(PG8_SB(1, 1), b3 + hstep, voffB);
            PG8_WAIT_V(6); PG8_BAR; PG8_MMA(1, 1, At, B1); PG8_BAR;
            }
        }
        typename Epi::Pre pre_;
        if constexpr (!Epi::AFTER_DRAIN) E.pre(pre_, cur, wr, wc, fr, fq, lds);
        if constexpr (ALIGN_EPI) { if (wr == 0) PG8_BAR; }
        if constexpr (!Epi::AFTER_DRAIN) { E(acc, cur, wr, wc, fr, fq, pre_); S.done(cur); }
        if (!has_next) break;
#pragma unroll
        for (int a = 0; a < 2; ++a)
#pragma unroll
            for (int b = 0; b < 2; ++b)
#pragma unroll
                for (int m = 0; m < 4; ++m)
#pragma unroll
                    for (int n = 0; n < 2; ++n) acc[a][b][m][n] = (f32x4){0.f, 0.f, 0.f, 0.f};
        cur = nxt; cA = nA; cB = nB; ++ui;
        if constexpr (ALIGN_EPI) { if (wr == 1) PG8_BAR; }
    }
    if constexpr (Epi::AFTER_DRAIN) {
        typename Epi::Pre pre_;
        const bool pf = E.pre(pre_, cur, wr, wc, fr, fq);
        if (pf) asm volatile("s_waitcnt vmcnt(16)" ::: "memory"); else PG8_WAIT_V(0);
        if constexpr (!ALIGN_EPI) { if (wr == 0) PG8_BAR; }
        PG8_BAR;
        E.fused(acc, cur, wr, wc, fr, fq, lds, wid, lane, pre_, pf); S.done(cur);
    } else {
        PG8_WAIT_V(0);
        if constexpr (!ALIGN_EPI) { if (wr == 0) PG8_BAR; }
        PG8_BAR;
    }
#undef PG8_SA
#undef PG8_SB
#undef PG8_STAGE
#undef PG8_LDA
#undef PG8_LDB
#undef PG8_MMA
#undef PG8_WAIT_V
#undef PG8_WAIT_L
#undef PG8_BAR
#undef PG8_SCHED
}
}

struct WS {
    unsigned* bar;
    bf16* hb;
    float* ssq;
    float* ssq1;
    bf16* hid;
    bf16* u0;
    bf16* qkv0;
    bf16* hg;
    float* flog;
    float* cum;
    float* segtot;
    bf16* ycat;
    bf16* w1o;
    bf16* qmla;
    bf16* kvmla;
    bf16* kcb; bf16* vcb;
    float* s5e;
    float* cb1;
    int* bkt;
    float* tbg;
    float* ropet;
    bf16* hkv; float* pq;
    bf16* wt_c1k; bf16* wt_c1v;
    bf16* wA1; bf16* wA2; bf16* wB1; bf16* wB2;
    bf16* wt_in0; bf16* wt_out0; bf16* wt_glu; bf16* wt_in1; bf16* wt_uq; bf16* wt_ukv; bf16* wt_out1;
};
struct GemmP {
    const bf16* A; int lda; int amode; int acoff;
    const float* W; const float* W2; int ldw; int bmode; int bcoff;
    const float* gain;
    int M, N, K;
    const float* PQ; const float* cb1;
};
__device__ __forceinline__ bool a_valid(const GemmP& g, int m) { return g.amode == 0 ? true : ((m & 511) < 511); }
__device__ __forceinline__ const bf16* a_ptr(const GemmP& g, int m, int k) {
    if (g.amode == 0) return g.A + (size_t)m * g.lda + k;
    int bg = m >> 9, i = m & 511, b = bg >> 1, gq = bg & 1, l = k >> 6, d = k & 63;
    return g.A + (size_t)(b * S + 16 * i + l) * g.lda + g.acoff + gq * 64 + d;
}
__device__ __forceinline__ uint4 a_load8(const GemmP& g, int m, int k) {
    if (g.amode != 2) return *(const uint4*)a_ptr(g, m, k);
    const float* pp = g.PQ + (size_t)m * 256 + k; const float* qq = g.PQ + (size_t)(m + 1) * 256 + 128 + k; const float* bb = g.cb1 + k;
    const f32x4 p0 = *(const f32x4*)pp, p1 = *(const f32x4*)(pp + 4), q0 = *(const f32x4*)qq, q1 = *(const f32x4*)(qq + 4), b0 = *(const f32x4*)bb, b1 = *(const f32x4*)(bb + 4);
    const f32x4 x0 = p0 + q0 + b0, x1 = p1 + q1 + b1;
    return make_uint4(pk2(gelu_tanh(x0[0]), gelu_tanh(x0[1])), pk2(gelu_tanh(x0[2]), gelu_tanh(x0[3])), pk2(gelu_tanh(x1[0]), gelu_tanh(x1[1])), pk2(gelu_tanh(x1[2]), gelu_tanh(x1[3])));
}
__device__ __forceinline__ const float* b_col(const GemmP& g, int n) {
    if (g.bmode == 0) return g.W + g.bcoff + n;
    if (g.bmode == 1) { int blk = n >> 4; int j = (n >> 5) * 16 + (n & 15); return ((blk & 1) ? g.W2 : g.W) + j; }
    if (g.bmode == 2) { int hh = n / 96, c = n - hh * 96; if (c < 64) return g.W + n; int r = c - 64; return g.W + hh * 96 + 64 + (r & 1) * 16 + (r >> 1); }
      { if (n >= C_KR && n < C_KR + 32) { int r = n - C_KR; return g.W + C_KR + (r & 1) * 16 + (r >> 1); } return g.W + n; }
}

__device__ __forceinline__ float rstd4(const float* ssq, int m) { const f32x4 v = *(const f32x4*)(ssq + (size_t)m * 4); return rsqrtf(((v[0] + v[1]) + (v[2] + v[3])) * (1.0f / 1024.0f) + 1e-6f); }
__device__ __forceinline__ u32x4 pk8(f32x4 a, f32x4 b) { return (u32x4){pk2(a[0], a[1]), pk2(a[2], a[3]), pk2(b[0], b[1]), pk2(b[2], b[3])}; }
struct EpiFFN1 {
    static constexpr bool SSQ = false, RS4 = true; bf16* hid; const float* ssq;
    __device__ __forceinline__ float rowscale(int m) const { return rstd4(ssq, m); }
    __device__ __forceinline__ void oct2(int m, int j0, f32x4 g0, f32x4 g1, f32x4 u0, f32x4 u1) const { f32x4 o0, o1;
#pragma unroll
        for (int i = 0; i < 4; ++i) { o0[i] = g0[i] * sigmoidf_(g0[i]) * u0[i]; o1[i] = g1[i] * sigmoidf_(g1[i]) * u1[i]; }
        *(u32x4*)(hid + (size_t)m * FF + j0) = pk8(o0, o1); }
    __device__ __forceinline__ void rowdone(int, int, float) const {}
};
struct EpiRes {
    static constexpr bool SSQ = true; const float* hin32; float* hout32; bf16* hb; float* ssq; const float* fgain; unsigned* fcnt; float scale; int pad_;
    struct R8 { f32x4 a, b; };
    __device__ __forceinline__ R8 load8(int m, int n0) const { R8 r;
        if (hin32) { r.a = *(const f32x4*)(hin32 + (size_t)m * D + n0); r.b = *(const f32x4*)(hin32 + (size_t)m * D + n0 + 4); }
        else { const u32x4 w = *(const u32x4*)(hb + (size_t)m * D + n0);
            r.a = (f32x4){__uint_as_float(w[0] << 16), __uint_as_float(w[0] & 0xffff0000u), __uint_as_float(w[1] << 16), __uint_as_float(w[1] & 0xffff0000u)};
            r.b = (f32x4){__uint_as_float(w[2] << 16), __uint_as_float(w[2] & 0xffff0000u), __uint_as_float(w[3] << 16), __uint_as_float(w[3] & 0xffff0000u)}; }
        return r; }
    __device__ __forceinline__ float finish8(int m, int n0, R8 x, f32x4 v0, f32x4 v1) const {
        x.a += v0 * scale; x.b += v1 * scale;
        if (hout32) { *(f32x4*)(hout32 + (size_t)m * D + n0) = x.a; *(f32x4*)(hout32 + (size_t)m * D + n0 + 4) = x.b; } else *(u32x4*)(hb + (size_t)m * D + n0) = pk8(x.a, x.b);
        const f32x4 q = x.a * x.a + x.b * x.b; return (q[0] + q[1]) + (q[2] + q[3]); }
};
struct EpiWin0 {
    static constexpr bool SSQ = false, RS4 = true; bf16* u0; bf16* qkv0; const float* ssq;
    __device__ __forceinline__ float rowscale(int m) const { return rstd4(ssq, m); }
    __device__ __forceinline__ float oct(int m, int n0, f32x4 v0, f32x4 v1) const {
        if (n0 < 512) *(u32x4*)(u0 + (size_t)m * 512 + n0) = pk8(v0, v1); else *(u32x4*)(qkv0 + (size_t)m * 1536 + (n0 - 512)) = pk8(v0, v1);
        return 0.f; }
    __device__ __forceinline__ void rowdone(int, int, float) const {}
};
struct EpiGlu {
    static constexpr bool SSQ = false, RS4 = false; const bf16* hg; const float* bglu; bf16* ycat;
    __device__ __forceinline__ float rowscale(int) const { return 1.f; }
    __device__ __forceinline__ float oct(int m, int n0, f32x4 v0, f32x4 v1) const { f32x4 o0, o1; const u32x4 hv = *(const u32x4*)(hg + (size_t)m * 512 + n0); const f32x4 b0 = *(const f32x4*)(bglu + n0), b1 = *(const f32x4*)(bglu + n0 + 4);
        o0[0] = __uint_as_float(hv[0] << 16) * sigmoidf_(v0[0] + b0[0]); o0[1] = __uint_as_float(hv[0] & 0xffff0000u) * sigmoidf_(v0[1] + b0[1]);
        o0[2] = __uint_as_float(hv[1] << 16) * sigmoidf_(v0[2] + b0[2]); o0[3] = __uint_as_float(hv[1] & 0xffff0000u) * sigmoidf_(v0[3] + b0[3]);
        o1[0] = __uint_as_float(hv[2] << 16) * sigmoidf_(v1[0] + b1[0]); o1[1] = __uint_as_float(hv[2] & 0xffff0000u) * sigmoidf_(v1[1] + b1[1]);
        o1[2] = __uint_as_float(hv[3] << 16) * sigmoidf_(v1[2] + b1[2]); o1[3] = __uint_as_float(hv[3] & 0xffff0000u) * sigmoidf_(v1[3] + b1[3]);
        *(u32x4*)(ycat + (size_t)m * D + n0) = pk8(o0, o1); return 0.f; }
    __device__ __forceinline__ void rowdone(int, int, float) const {}
};
__device__ __forceinline__ void rope2(f32x4& v, int i0, int pos, const float* ropet) {
    const f32x4 cs = *(const f32x4*)(ropet + ((size_t)pos * 16 + i0) * 2);
    const float x1 = v[0], x2 = v[1], y1 = v[2], y2 = v[3];
    v[0] = x1 * cs[0] - x2 * cs[1]; v[1] = x2 * cs[0] + x1 * cs[1]; v[2] = y1 * cs[2] - y2 * cs[3]; v[3] = y2 * cs[2] + y1 * cs[3];
}
struct EpiWin1 {
    static constexpr bool SSQ = true, RS4 = true; bf16* w1o; const float* ssq; float* ssq1; const float* ropet; bf16* hkv;
    __device__ __forceinline__ float rowscale(int m) const { return rstd4(ssq, m); }
    __device__ __forceinline__ float oct(int m, int n0, f32x4 v0, f32x4 v1) const {
        if (n0 >= ODD_IN) return 0.f;
        const f32x4 q2 = v0 * v0 + v1 * v1; const float ss = (q2[0] + q2[1]) + (q2[2] + q2[3]);
        if (n0 >= C_KR && n0 < C_KR + 32) { rope2(v0, (n0 - C_KR) >> 1, m & (S - 1), ropet); rope2(v1, ((n0 - C_KR) >> 1) + 2, m & (S - 1), ropet); }
        if (n0 >= C_KC && n0 < C_KC + 256) { const int c = n0 - C_KC, kv = c >> 7, gq = (c >> 6) & 1, d = c & 63, bb = m >> 13, tl = m & (S - 1);
            *(u32x4*)(hkv + (size_t)kv * 2048 * 1024 + ((size_t)(bb * 2 + gq) * 512 + (tl >> 4)) * 1024 + (tl & 15) * 64 + d) = pk8(v0, v1); return ss; }
        *(u32x4*)(w1o + (size_t)m * LDW1 + n0) = pk8(v0, v1); return ss; }
    __device__ __forceinline__ void rowdone(int m, int cb, float ss) const { if (cb < 20) ssq1[(size_t)m * 32 + cb] = ss; }
};
struct EpiUq {
    static constexpr bool SSQ = false, RS4 = false; bf16* qmla; const float* ssq1; const float* ropet;
    __device__ __forceinline__ float rowscale(int m) const { const f32x4 a = *(const f32x4*)(ssq1 + (size_t)m * 32), b = *(const f32x4*)(ssq1 + (size_t)m * 32 + 4), c = *(const f32x4*)(ssq1 + (size_t)m * 32 + 8);
        const f32x4 t = a + b + c; return rsqrtf(((t[0] + t[1]) + (t[2] + t[3])) * (1.0f / 384.0f) + 1e-6f); }
    __device__ __forceinline__ float oct(int m, int n0, f32x4 v0, f32x4 v1) const { const int hh = n0 / 96, c = n0 - hh * 96;
        if (c >= 64) { rope2(v0, (c - 64) >> 1, m & (S - 1), ropet); rope2(v1, ((c - 64) >> 1) + 2, m & (S - 1), ropet); }
        *(u32x4*)(qmla + (size_t)m * 768 + n0) = pk8(v0, v1); return 0.f; }
    __device__ __forceinline__ void rowdone(int, int, float) const {}
};
struct EpiUkv {
    static constexpr bool SSQ = false, RS4 = false; bf16* kvmla; const float* ssq1;
    __device__ __forceinline__ float rowscale(int m) const { const f32x4 a = *(const f32x4*)(ssq1 + (size_t)m * 32 + 12), b = *(const f32x4*)(ssq1 + (size_t)m * 32 + 16);
        const f32x4 t = a + b; return rsqrtf(((t[0] + t[1]) + (t[2] + t[3])) * (1.0f / 256.0f) + 1e-6f); }
    __device__ __forceinline__ float oct(int m, int n0, f32x4 v0, f32x4 v1) const { *(u32x4*)(kvmla + (size_t)m * 1024 + n0) = pk8(v0, v1); return 0.f; }
    __device__ __forceinline__ void rowdone(int, int, float) const {}
};
struct EpiPQ {
    static constexpr bool SSQ = false, RS4 = false; float* pq;
    __device__ __forceinline__ float rowscale(int) const { return 1.f; }
    __device__ __forceinline__ float oct(int m, int n0, f32x4 v0, f32x4 v1) const { *(f32x4*)(pq + (size_t)m * 256 + n0) = v0; *(f32x4*)(pq + (size_t)m * 256 + n0 + 4) = v1; return 0.f; }
    __device__ __forceinline__ void rowdone(int, int, float) const {}
};
struct EpiCmp2 {
    static constexpr bool SSQ = false; bf16* outb;
    __device__ __forceinline__ float rowscale(int) const { return 1.f; }
    __device__ __forceinline__ float quad(int m, int n0, f32x4 v) const { if (n0 < 64) *(uint2*)(outb + (size_t)m * 64 + n0) = pk4(v); return 0.f; }
    __device__ __forceinline__ void rowdone(int, int, float) const {}
};
template <class E, bool DUAL>
struct PgEpi {
    static constexpr bool PERM = true, AFTER_DRAIN = false; E e;
    using Pre = f32x4[2][4];
    static constexpr bool RSDMA = E::RS4;
    __device__ __forceinline__ const float* rs_src() const { if constexpr (E::RS4) return e.ssq; else return nullptr; }
    __device__ __forceinline__ void pre(Pre& p, const pg8::Unit&, int wr, int, int fr, int, PG8_LAS unsigned char* lds) const {
        if constexpr (E::RS4) {
#pragma unroll
            for (int ai = 0; ai < 2; ++ai)
#pragma unroll
                for (int m = 0; m < 4; ++m) p[ai][m] = *(const PG8_LAS f32x4*)(lds + pg8::STAGE_BYTES + (ai * 128 + wr * 64 + m * 16 + fr) * 16);
        }
    }
    __device__ __forceinline__ void operator()(const f32x4 (&acc)[2][2][4][2], const pg8::Unit& u, int wr, int wc, int fr, int fq, const Pre& p) const {
#pragma unroll
        for (int ai = 0; ai < 2; ++ai) {
            float rs[4];
#pragma unroll
            for (int m = 0; m < 4; ++m) {
                if constexpr (E::RS4) { const f32x4 v = p[ai][m]; rs[m] = __builtin_amdgcn_rsqf(((v[0] + v[1]) + (v[2] + v[3])) * (1.0f / 1024.0f) + 1e-6f); }
                else rs[m] = e.rowscale(u.pm * 256 + ai * 128 + wr * 64 + m * 16 + fr); }
#pragma unroll
            for (int m = 0; m < 4; ++m) { const int row = u.pm * 256 + ai * 128 + wr * 64 + m * 16 + fr; const float rsv = rs[m];
                if constexpr (DUAL) e.oct2(row, u.pn * 128 + wc * 32 + fq * 8, acc[ai][0][m][0] * rsv, acc[ai][0][m][1] * rsv, acc[ai][1][m][0] * rsv, acc[ai][1][m][1] * rsv);
                else {
#pragma unroll
                    for (int bj = 0; bj < 2; ++bj) { float ss = e.oct(row, u.pn * 256 + bj * 128 + wc * 32 + fq * 8, acc[ai][bj][m][0] * rsv, acc[ai][bj][m][1] * rsv);
                        if constexpr (E::SSQ) { ss = xrow16_sum(ss); if (fq == 0) e.rowdone(row, (u.pn * 2 + bj) * 4 + wc, ss); } } }
                asm volatile("" ::: "memory"); } }
    }
};
struct PgEpiRes {
    static constexpr bool PERM = true, AFTER_DRAIN = true, RSDMA = false; EpiRes e;
    using Pre = u32x4[8][2];
    __device__ __forceinline__ bool pre(Pre& p, const pg8::Unit& u, int wr, int wc, int fr, int fq) const {
        if (e.hin32) return false;
#pragma unroll
        for (int g = 0; g < 8; ++g) { const int row = u.pm * 256 + (g >> 2) * 128 + wr * 64 + (g & 3) * 16 + fr;
#pragma unroll
            for (int bj = 0; bj < 2; ++bj) p[g][bj] = *(const u32x4*)(e.hb + (size_t)row * D + u.pn * 256 + bj * 128 + wc * 32 + fq * 8); }
        return true;
    }
    __device__ __forceinline__ void fused(f32x4 (&acc)[2][2][4][2], const pg8::Unit& u, int wr, int wc, int fr, int fq, PG8_LAS unsigned char* lds, int wid, int lane, const Pre& p, bool pf) const {
        PG8_LAS float* red = (PG8_LAS float*)lds;
        const bool fin = e.fgain != nullptr;
        if (pf) {
#pragma unroll
            for (int g = 0; g < 8; ++g) { const int ai = g >> 2, m = g & 3, rl = ai * 128 + wr * 64 + m * 16 + fr, row = u.pm * 256 + rl; float ss = 0.f;
#pragma unroll
                for (int bj = 0; bj < 2; ++bj) { const u32x4 w = p[g][bj]; EpiRes::R8 x;
                    x.a = (f32x4){__uint_as_float(w[0] << 16), __uint_as_float(w[0] & 0xffff0000u), __uint_as_float(w[1] << 16), __uint_as_float(w[1] & 0xffff0000u)};
                    x.b = (f32x4){__uint_as_float(w[2] << 16), __uint_as_float(w[2] & 0xffff0000u), __uint_as_float(w[3] << 16), __uint_as_float(w[3] & 0xffff0000u)};
                    x.a += acc[ai][bj][m][0] * e.scale; x.b += acc[ai][bj][m][1] * e.scale;
                    if (fin) { acc[ai][bj][m][0] = x.a; acc[ai][bj][m][1] = x.b; }
                    else *(u32x4*)(e.hb + (size_t)row * D + u.pn * 256 + bj * 128 + wc * 32 + fq * 8) = pk8(x.a, x.b);
                    const f32x4 q = x.a * x.a + x.b * x.b; ss += (q[0] + q[1]) + (q[2] + q[3]); }
                ss = xrow16_sum(ss); if (fq == 0) red[rl * 4 + wc] = ss; }
        } else {
        EpiRes::R8 xa[2], xb[2];
#define RES_LOAD(dst_, g_) do { const int ai_ = (g_) >> 2, m_ = (g_) & 3; const int row_ = u.pm * 256 + ai_ * 128 + wr * 64 + m_ * 16 + fr; \
            _Pragma("unroll") for (int bj = 0; bj < 2; ++bj) dst_[bj] = e.load8(row_, u.pn * 256 + bj * 128 + wc * 32 + fq * 8); } while (0)
#define RES_DO(src_, g_) do { const int ai_ = (g_) >> 2, m_ = (g_) & 3; const int rl_ = ai_ * 128 + wr * 64 + m_ * 16 + fr, row_ = u.pm * 256 + rl_; float ss_ = 0.f; \
            _Pragma("unroll") for (int bj = 0; bj < 2; ++bj) ss_ += e.finish8(row_, u.pn * 256 + bj * 128 + wc * 32 + fq * 8, src_[bj], acc[ai_][bj][m_][0], acc[ai_][bj][m_][1]); \
            ss_ = xrow16_sum(ss_); if (fq == 0) red[rl_ * 4 + wc] = ss_; } while (0)
        RES_LOAD(xa, 0);
#pragma unroll
        for (int gp = 0; gp < 8; gp += 2) {
            RES_LOAD(xb, gp + 1); RES_DO(xa, gp); asm volatile("" ::: "memory");
            if (gp + 2 < 8) RES_LOAD(xa, gp + 2);
            RES_DO(xb, gp + 1); asm volatile("" ::: "memory");
        }
#undef RES_LOAD
#undef RES_DO
        }
        __syncthreads();
        const int t = threadIdx.x;
        if (t < 256) { const f32x4 r = *(const PG8_LAS f32x4*)(red + t * 4); const float sv = (r[0] + r[1]) + (r[2] + r[3]); float* sp_ = e.ssq + (size_t)(u.pm * 256 + t) * 4 + u.pn;
            if (fin) __hip_atomic_store(sp_, sv, __ATOMIC_RELAXED, __HIP_MEMORY_SCOPE_AGENT); else *sp_ = sv; }
        if (fin) {
            PG8_LAS float* rsl = red + 1024;
            unsigned* cnt = e.fcnt + u.pm * 64;
            asm volatile("s_waitcnt vmcnt(0)" ::: "memory");
            __syncthreads();
            if (t == 0) { __hip_atomic_fetch_add(cnt, 1u, __ATOMIC_RELAXED, __HIP_MEMORY_SCOPE_AGENT); unsigned sp = 0u;
                while (__hip_atomic_load(cnt, __ATOMIC_RELAXED, __HIP_MEMORY_SCOPE_AGENT) < 4u) { __builtin_amdgcn_s_sleep(1); if (++sp > (1u << 24)) break; }
                __builtin_amdgcn_fence(__ATOMIC_ACQUIRE, "agent"); asm volatile("s_waitcnt vmcnt(0)" ::: "memory"); }
            __syncthreads();
            if (t < 256) { const float* sp_ = e.ssq + (size_t)(u.pm * 256 + t) * 4;
                const float s0 = __hip_atomic_load(sp_, __ATOMIC_RELAXED, __HIP_MEMORY_SCOPE_AGENT), s1 = __hip_atomic_load(sp_ + 1, __ATOMIC_RELAXED, __HIP_MEMORY_SCOPE_AGENT),
                            s2 = __hip_atomic_load(sp_ + 2, __ATOMIC_RELAXED, __HIP_MEMORY_SCOPE_AGENT), s3 = __hip_atomic_load(sp_ + 3, __ATOMIC_RELAXED, __HIP_MEMORY_SCOPE_AGENT);
                rsl[t] = rsqrtf(((s0 + s1) + (s2 + s3)) * (1.0f / 1024.0f) + 1e-6f); }
            __syncthreads();
            f32x4 gn[2][2];
#pragma unroll
            for (int bj = 0; bj < 2; ++bj) { const int n0 = u.pn * 256 + bj * 128 + wc * 32 + fq * 8; gn[bj][0] = *(const f32x4*)(e.fgain + n0); gn[bj][1] = *(const f32x4*)(e.fgain + n0 + 4); }
#pragma unroll
            for (int g = 0; g < 8; ++g) { const int ai = g >> 2, m = g & 3, rl = ai * 128 + wr * 64 + m * 16 + fr; const float rs = rsl[rl]; float* op = e.hout32 + (size_t)(u.pm * 256 + rl) * D + u.pn * 256 + wc * 32 + fq * 8;
#pragma unroll
                for (int bj = 0; bj < 2; ++bj) { *(f32x4*)(op + bj * 128) = acc[ai][bj][m][0] * rs * gn[bj][0]; *(f32x4*)(op + bj * 128 + 4) = acc[ai][bj][m][1] * rs * gn[bj][1]; } }
        }
    }
};
__device__ __forceinline__ void res_gemm(const bf16* A, int lda, const bf16* Bt, int K, const EpiRes& e, char* smem, int G, int bid) {
    asm volatile("" : "+s"(K), "+s"(lda));
    pg8::Gemm g{A, Bt, T, D, K, lda}; pg8::StaticOrder so; so.init(T, D, G, bid);
    const PgEpiRes pe{e};
    pg8::gemm_phase<PgEpiRes, pg8::StaticOrder, false, true>((PG8_LAS unsigned char*)smem, g, so, pe);
}
template <class E, bool DUAL>
__device__ __forceinline__ void big_gemm(const bf16* A, int lda, const bf16* Bt, int M, int N, int K, const E& e, char* smem, int G, int bid) {
    asm volatile("" : "+s"(K), "+s"(lda), "+s"(N));
    pg8::Gemm g{A, Bt, M, N, K, lda}; pg8::StaticOrder so; so.init(M, N, G, bid);
    const PgEpi<E, DUAL> pe{e};
    pg8::gemm_phase<PgEpi<E, DUAL>, pg8::StaticOrder, true, true>((PG8_LAS unsigned char*)smem, g, so, pe);
}

constexpr int G_LDS = 72;
constexpr int G_SMEM = 2 * 128 * G_LDS * 2;
template <class Epi, bool DUAL>
__device__ __forceinline__ void gemm_tile(const GemmP& g, const Epi& e, int tm, int tn, bf16* smem) {
    bf16* As = smem; bf16* Bs = smem + 128 * G_LDS;
    int tid_ = threadIdx.x & 255; asm volatile("" : "+v"(tid_)); const int tid = tid_, lane = tid & 63, wave = tid >> 6, wm = wave >> 1, wn = wave & 1;
    const int m0 = tm * 128, n0 = tn * 128;
    const int bn = tid & 127, bkh = tid >> 7;
    const bool bvalid = (n0 + bn) < g.N;
    const float* bcol = b_col(g, bvalid ? n0 + bn : 0);
    uint4 ra[4]; float rb[32];
    const int nkt = g.K / 64;
    auto load_tile = [&](int kt) {
#pragma unroll
        for (int i = 0; i < 4; ++i) { int c = tid + i * 256, row = c >> 3, kc = c & 7; int m = m0 + row;
            ra[i] = a_valid(g, m) ? a_load8(g, m, kt * 64 + kc * 8) : make_uint4(0, 0, 0, 0); }
        const float* bp = bcol + (size_t)(kt * 64 + bkh * 32) * g.ldw;
#pragma unroll
        for (int j = 0; j < 32; ++j) rb[j] = bvalid ? bp[(size_t)j * g.ldw] : 0.f;
        if (g.gain) { const float* gp = g.gain + kt * 64 + bkh * 32;
#pragma unroll
            for (int j = 0; j < 32; ++j) rb[j] *= gp[j]; }
    };
    auto store_tile = [&]() {
#pragma unroll
        for (int i = 0; i < 4; ++i) { int c = tid + i * 256, row = c >> 3, kc = c & 7; *(uint4*)(As + row * G_LDS + kc * 8) = ra[i]; }
#pragma unroll
        for (int q = 0; q < 4; ++q) { uint4 w;
            w.x = f2bf(rb[q * 8 + 0]) | ((unsigned)f2bf(rb[q * 8 + 1]) << 16); w.y = f2bf(rb[q * 8 + 2]) | ((unsigned)f2bf(rb[q * 8 + 3]) << 16);
            w.z = f2bf(rb[q * 8 + 4]) | ((unsigned)f2bf(rb[q * 8 + 5]) << 16); w.w = f2bf(rb[q * 8 + 6]) | ((unsigned)f2bf(rb[q * 8 + 7]) << 16);
            *(uint4*)(Bs + bn * G_LDS + bkh * 32 + q * 8) = w; }
    };
    f32x4 acc[4][4];
#pragma unroll
    for (int i = 0; i < 4; ++i)
#pragma unroll
        for (int j = 0; j < 4; ++j) acc[i][j] = (f32x4){0.f, 0.f, 0.f, 0.f};
    load_tile(0);
    for (int kt = 0; kt < nkt; ++kt) {
        __syncthreads();
        store_tile();
        __syncthreads();
        if (kt + 1 < nkt) load_tile(kt + 1);
#pragma unroll
        for (int kk = 0; kk < 2; ++kk) {
            bf16x8 a[4], b[4];
#pragma unroll
            for (int i = 0; i < 4; ++i) a[i] = *(const bf16x8*)(As + (wm * 64 + i * 16 + (lane & 15)) * G_LDS + kk * 32 + (lane >> 4) * 8);
#pragma unroll
            for (int j = 0; j < 4; ++j) b[j] = *(const bf16x8*)(Bs + (wn * 64 + j * 16 + (lane & 15)) * G_LDS + kk * 32 + (lane >> 4) * 8);
#pragma unroll
            for (int i = 0; i < 4; ++i)
#pragma unroll
                for (int j = 0; j < 4; ++j) acc[i][j] = __builtin_amdgcn_mfma_f32_16x16x32_bf16(b[j], a[i], acc[i][j], 0, 0, 0);
        }
    }
#pragma unroll
    for (int i = 0; i < 4; ++i) { const int m = m0 + wm * 64 + i * 16 + (lane & 15); const float rsv = e.rowscale(m); float ss = 0.f;
        if constexpr (DUAL) {
#pragma unroll
            for (int jj = 0; jj < 2; ++jj) ss += e.quad2(m, tn * 64 + wn * 32 + jj * 16 + (lane >> 4) * 4, acc[i][2 * jj] * rsv, acc[i][2 * jj + 1] * rsv);
        } else {
#pragma unroll
            for (int j = 0; j < 4; ++j) ss += e.quad(m, n0 + wn * 64 + j * 16 + (lane >> 4) * 4, acc[i][j] * rsv);
        }
        if constexpr (Epi::SSQ) { ss = xrow16_sum(ss); if ((lane >> 4) == 0) e.rowdone(m, 0, ss); }
    }
}


struct AttnP {
    const bf16* q; int ldq; const bf16* k; int ldk; const bf16* v; int ldv; const bf16* k2;
    const float* cum; const float* relb; const int* bkt; const float* tbg;
    const bf16* gl; const float* bgate; bf16* out; int ldo; const float* segtot;
    const bf16* kw; const bf16* vw; const bf16* kcb; const bf16* vcb;
};

constexpr int IMPS = 129, YST = 68;
constexpr int KB64 = 64 * 80 * 2, KB96 = 64 * 112 * 2, VBUF = 64 * 80 * 2;
constexpr int OFF_TB = 0, OFF_CKS = 4096, OFF_RING = OFF_CKS + 4 * 256, OFF_IMP = OFF_RING + 4 * KB64 + 4 * VBUF, OFF_SELW = OFF_IMP + 2 * 64 * IMPS * 4, OFF_Y = OFF_IMP  ,
              FL_SMEM = OFF_Y + 8 * 32 * YST * 4;
static_assert(OFF_RING + 4 * KB96 + 4 * VBUF <= FL_SMEM && OFF_SELW + 64 * 16 <= FL_SMEM && FL_SMEM + 16 <= 160 * 1024, "attention LDS map");
__device__ __forceinline__ float cum_at(const float* cum, const float (&pre8)[8], size_t rowb, int t, int hq) { return cum[(rowb + t) * 8 + hq] + pre8[t >> 10]; }
struct FCtx { int b, hq, hkv, qw0, qb_lo, qb_hi; };

template <int NKS, int KST>
__device__ __forceinline__ void qk_tile(const bf16* Ks, const bf16x8 (&qf)[2][NKS], f32x4 (&sc)[2][4], int l15, int quad) {
#pragma unroll
    for (int qt = 0; qt < 2; ++qt)
#pragma unroll
        for (int kt = 0; kt < 4; ++kt) sc[qt][kt] = (f32x4){0.f, 0.f, 0.f, 0.f};
    __builtin_amdgcn_s_setprio(1);
#pragma unroll
    for (int ks = 0; ks < NKS; ++ks)
#pragma unroll
        for (int kt = 0; kt < 4; ++kt) { const bf16x8 kf = *(const bf16x8*)(Ks + (kt * 16 + l15) * KST + ks * 32 + quad * 8);
#pragma unroll
            for (int qt = 0; qt < 2; ++qt) sc[qt][kt] = __builtin_amdgcn_mfma_f32_16x16x32_bf16(kf, qf[qt][ks], sc[qt][kt], 0, 0, 0); }
    __builtin_amdgcn_s_setprio(0);
}
__device__ __forceinline__ void pv_tile(const bf16* Vs, const unsigned (&pb)[2][4][2], f32x4 (&o)[2][4], int lane) {
    constexpr int VST = 80; const int l15 = lane & 15, quad = lane >> 4;
    __builtin_amdgcn_s_setprio(1);
#pragma unroll
    for (int ks2 = 0; ks2 < 2; ++ks2) {
        bf16x8 pf[2];
#pragma unroll
        for (int qt = 0; qt < 2; ++qt) { const u32x4 t4 = {pb[qt][2 * ks2][0], pb[qt][2 * ks2][1], pb[qt][2 * ks2 + 1][0], pb[qt][2 * ks2 + 1][1]}; pf[qt] = __builtin_bit_cast(bf16x8, t4); }
#pragma unroll
        for (int dvt = 0; dvt < 4; ++dvt) {
            const bf16* a0 = Vs + (ks2 * 32 + quad * 4 + (l15 >> 2)) * VST + dvt * 16 + (lane & 3) * 4;
            const s16x4 v0 = __builtin_amdgcn_ds_read_tr16_b64_v4i16((LDS_AS s16x4*)a0);
            const s16x4 v1 = __builtin_amdgcn_ds_read_tr16_b64_v4i16((LDS_AS s16x4*)(a0 + 16 * VST));
            bf16x8 vf; vf[0] = v0[0]; vf[1] = v0[1]; vf[2] = v0[2]; vf[3] = v0[3]; vf[4] = v1[0]; vf[5] = v1[1]; vf[6] = v1[2]; vf[7] = v1[3];
#pragma unroll
            for (int qt = 0; qt < 2; ++qt) o[qt][dvt] = __builtin_amdgcn_mfma_f32_16x16x32_bf16(vf, pf[qt], o[qt][dvt], 0, 0, 0);
        }
    }
    __builtin_amdgcn_s_setprio(0);
}

template <int CTRL> __device__ __forceinline__ float dppf(float x) { return __builtin_bit_cast(float, __builtin_amdgcn_mov_dpp(__builtin_bit_cast(int, x), CTRL, 0xf, 0xf, true)); }
template <int CTRL> __device__ __forceinline__ int dppi(int x) { return __builtin_amdgcn_mov_dpp(x, CTRL, 0xf, 0xf, true); }
constexpr int DPP_XOR1 = 0xB1, DPP_XOR2 = 0x4E, DPP_HMIRROR = 0x141;
template <int WHICH>
__device__ __forceinline__ void qk_tile_sel(const bf16* Ks, const bf16x8 (&qf)[2][2], f32x4 (&sc)[2][4], int l15, int quad) {
    constexpr int KST = 80;
#pragma unroll
    for (int qt = 0; qt < 2; ++qt)
#pragma unroll
        for (int kt = 0; kt < 4; ++kt) sc[qt][kt] = (f32x4){0.f, 0.f, 0.f, 0.f};
#pragma unroll
    for (int ks = 0; ks < 2; ++ks)
#pragma unroll
        for (int kt = 0; kt < 4; ++kt) { const bf16x8 kf = *(const bf16x8*)(Ks + (kt * 16 + l15) * KST + ks * 32 + quad * 8);
            if (WHICH != 2) sc[0][kt] = __builtin_amdgcn_mfma_f32_16x16x32_bf16(kf, qf[0][ks], sc[0][kt], 0, 0, 0);
            if (WHICH != 1) sc[1][kt] = __builtin_amdgcn_mfma_f32_16x16x32_bf16(kf, qf[1][ks], sc[1][kt], 0, 0, 0); }
}
__device__ __forceinline__ void qk_tile_en(const bf16* Ks, const bf16x8 (&qf)[2][2], f32x4 (&sc)[2][4], int l15, int quad, bool e0, bool e1) {
    if (e0 && e1) qk_tile_sel<0>(Ks, qf, sc, l15, quad); else if (e0) qk_tile_sel<1>(Ks, qf, sc, l15, quad); else qk_tile_sel<2>(Ks, qf, sc, l15, quad);
}
template <int WHICH>
__device__ __forceinline__ void pv_tile_sel(const bf16* Vs, const unsigned (&pb)[2][4][2], f32x4 (&o)[2][4], int lane) {
    constexpr int VST = 80; const int l15 = lane & 15, quad = lane >> 4;
#pragma unroll
    for (int ks2 = 0; ks2 < 2; ++ks2) {
        bf16x8 pf[2];
#pragma unroll
        for (int qt = 0; qt < 2; ++qt) { const u32x4 t4 = {pb[qt][2 * ks2][0], pb[qt][2 * ks2][1], pb[qt][2 * ks2 + 1][0], pb[qt][2 * ks2 + 1][1]}; pf[qt] = __builtin_bit_cast(bf16x8, t4); }
#pragma unroll
        for (int dvt = 0; dvt < 4; ++dvt) {
            const bf16* a0 = Vs + (ks2 * 32 + quad * 4 + (l15 >> 2)) * VST + dvt * 16 + (lane & 3) * 4;
            const s16x4 v0 = __builtin_amdgcn_ds_read_tr16_b64_v4i16((LDS_AS s16x4*)a0);
            const s16x4 v1 = __builtin_amdgcn_ds_read_tr16_b64_v4i16((LDS_AS s16x4*)(a0 + 16 * VST));
            bf16x8 vf; vf[0] = v0[0]; vf[1] = v0[1]; vf[2] = v0[2]; vf[3] = v0[3]; vf[4] = v1[0]; vf[5] = v1[1]; vf[6] = v1[2]; vf[7] = v1[3];
            if (WHICH != 2) o[0][dvt] = __builtin_amdgcn_mfma_f32_16x16x32_bf16(vf, pf[0], o[0][dvt], 0, 0, 0);
            if (WHICH != 1) o[1][dvt] = __builtin_amdgcn_mfma_f32_16x16x32_bf16(vf, pf[1], o[1][dvt], 0, 0, 0);
        }
    }
}
__device__ __forceinline__ void pv_tile_en(const bf16* Vs, const unsigned (&pb)[2][4][2], f32x4 (&o)[2][4], int lane, bool e0, bool e1) {
    if (e0 && e1) pv_tile_sel<0>(Vs, pb, o, lane); else if (e0) pv_tile_sel<1>(Vs, pb, o, lane); else pv_tile_sel<2>(Vs, pb, o, lane);
}

template <int MODE>
__device__ __forceinline__ void fl_tile(char* smem, int tile, int cur, int qw0, int qr0, int qr1, int hl, int l15, int quad, int lane, float SL, float c31, const float (&cq)[2],
                                        const u32x4 mwA, const u32x4 mwB, const bf16x8 (&qf)[2][(MODE == 1) ? 3 : 2], float (&m)[2], float (&l)[2], f32x4 (&o)[2][4]) {
    constexpr bool NM = (MODE >= 2);
    constexpr int DK = (MODE == 1) ? 96 : 64, KST = DK + 16, NKS = DK / 32, QSPAN = NM ? 8 : 32;
    const float* tb = (const float*)(smem + OFF_TB);
    const int kbase = tile * 64;
    bool skip = (kbase > qw0 + QSPAN - 1) || (MODE == 2 && kbase + 63 < qw0 - 511);
    bool bit0 = true, bit1 = true, en0 = true, en1 = true;
    if (MODE == 3) { const unsigned wa = (tile < 32) ? mwA[0] : (tile < 64) ? mwA[1] : (tile < 96) ? mwA[2] : mwA[3], wb = (tile < 32) ? mwB[0] : (tile < 64) ? mwB[1] : (tile < 96) ? mwB[2] : mwB[3];
        bit0 = (wa >> (tile & 31)) & 1u; bit1 = (wb >> (tile & 31)) & 1u;
        en0 = __builtin_amdgcn_ballot_w64(bit0) != 0ull; en1 = __builtin_amdgcn_ballot_w64(bit1) != 0ull; skip = skip || !(en0 || en1); }
    if (skip) return;
    constexpr int KB = (MODE == 1) ? KB96 : KB64;
    const bf16* Ks = (const bf16*)(smem + OFF_RING + cur * KB); const bf16* Vs = (const bf16*)(smem + OFF_RING + 4 * KB + cur * VBUF); const float* cks = (const float*)(smem + OFF_CKS) + cur * 64;
    f32x4 sc[2][4];
    if constexpr (MODE == 3) qk_tile_en(Ks, qf, sc, l15, quad, en0, en1); else qk_tile<NKS, KST>(Ks, qf, sc, l15, quad);
    unsigned pb[2][4][2];
    const bool edge = (kbase + 63 > qw0) || (MODE == 2 && kbase < qw0 + QSPAN - 1 - 511);
    const bool near = (MODE >= 2) && (kbase + 63 >= qw0 - 127);
    if (edge || near || MODE == 0) {
        f32x4 ckv[4];
        if (MODE == 0) {
#pragma unroll
            for (int kt = 0; kt < 4; ++kt) ckv[kt] = *(const f32x4*)(cks + kt * 16 + quad * 4); }
#pragma unroll
        for (int qt = 0; qt < 2; ++qt) {
            if (MODE == 3 && !(qt ? en1 : en0)) continue;
            const int q = qt ? qr1 : qr0; const bool bit = qt ? bit1 : bit0;
            float mx = -INFINITY;
#pragma unroll
            for (int kt = 0; kt < 4; ++kt)
#pragma unroll
                for (int r = 0; r < 4; ++r) { const int key = kbase + kt * 16 + quad * 4 + r; float bs = 0.f;
                    if (MODE == 0) bs = cq[qt] - ckv[kt][r];
                    if (MODE >= 2) { const int dd = q - key; bs = c31; if (near) { int di = dd < 0 ? 0 : (dd > 127 ? 127 : dd); const float tv = tb[hl * 136 + di]; bs = dd < 128 ? tv : c31; } }
                    float x = __builtin_fmaf(sc[qt][kt][r], SL, bs);
                    if (MODE != 0 || edge) { bool valid = key <= q; if (MODE == 2) valid = valid && (q - key < 512); if (MODE == 3) valid = valid && bit; x = valid ? x : -INFINITY; }
                    sc[qt][kt][r] = x; mx = fmaxf(mx, x); }
            mx = xrow16_max(mx);
            const float mn = fmaxf(m[qt], mx), ms = (mn == -INFINITY) ? 0.f : mn;
            const float alpha = __builtin_amdgcn_exp2f(m[qt] - ms); m[qt] = mn;
            float rsum = 0.f;
#pragma unroll
            for (int kt = 0; kt < 4; ++kt) { const float e0 = __builtin_amdgcn_exp2f(sc[qt][kt][0] - ms), e1 = __builtin_amdgcn_exp2f(sc[qt][kt][1] - ms), e2 = __builtin_amdgcn_exp2f(sc[qt][kt][2] - ms), e3 = __builtin_amdgcn_exp2f(sc[qt][kt][3] - ms);
                rsum += (e0 + e1) + (e2 + e3); pb[qt][kt][0] = pk2(e0, e1); pb[qt][kt][1] = pk2(e2, e3); }
            l[qt] = l[qt] * alpha + rsum;
            if (__builtin_amdgcn_ballot_w64(alpha != 1.0f) != 0ull) {
#pragma unroll
                for (int d = 0; d < 4; ++d) o[qt][d] *= alpha; }
        }
    } else {
#pragma unroll
        for (int qt = 0; qt < 2; ++qt) {
            if (MODE == 3 && !(qt ? en1 : en0)) continue;
            float bq = 0.f;
            if (MODE >= 2) bq = c31;
            if (MODE == 3) { if (!(qt ? bit1 : bit0)) bq = -INFINITY; }
            float mx = -INFINITY;
#pragma unroll
            for (int kt = 0; kt < 4; ++kt) mx = fmaxf(fmaxf(mx, fmaxf(sc[qt][kt][0], sc[qt][kt][1])), fmaxf(sc[qt][kt][2], sc[qt][kt][3]));
            mx = xrow16_max(mx);
            const float xm = __builtin_fmaf(mx, SL, bq);
            const float mn = fmaxf(m[qt], xm), ms = (mn == -INFINITY) ? 0.f : mn;
            const float alpha = __builtin_amdgcn_exp2f(m[qt] - ms); m[qt] = mn;
            const float off = bq - ms; float rsum = 0.f;
#pragma unroll
            for (int kt = 0; kt < 4; ++kt) { const float e0 = __builtin_amdgcn_exp2f(__builtin_fmaf(sc[qt][kt][0], SL, off)), e1 = __builtin_amdgcn_exp2f(__builtin_fmaf(sc[qt][kt][1], SL, off)),
                                                         e2 = __builtin_amdgcn_exp2f(__builtin_fmaf(sc[qt][kt][2], SL, off)), e3 = __builtin_amdgcn_exp2f(__builtin_fmaf(sc[qt][kt][3], SL, off));
                rsum += (e0 + e1) + (e2 + e3); pb[qt][kt][0] = pk2(e0, e1); pb[qt][kt][1] = pk2(e2, e3); }
            l[qt] = l[qt] * alpha + rsum;
            if (__builtin_amdgcn_ballot_w64(alpha != 1.0f) != 0ull) {
#pragma unroll
                for (int d = 0; d < 4; ++d) o[qt][d] *= alpha; }
        }
    }
    if constexpr (MODE == 3) pv_tile_en(Vs, pb, o, lane, en0, en1); else pv_tile(Vs, pb, o, lane);
}

template <int MODE>
__device__ __forceinline__ bool fl_tile2(char* smem, int tile, int cur, int qw0, int hl, int l15, int quad, int lane, float SL, float c31,
                                         const u32x4 mwA, const u32x4 mwB, const bf16x8 (&qf)[2][(MODE == 1) ? 3 : 2], float (&m)[2], float (&l)[2], f32x4 (&o)[2][4]) {
    static_assert(MODE == 1 || MODE == 3, "merged step: MLA and NSA-select only");
    constexpr bool NM = (MODE >= 2);
    constexpr int DK = (MODE == 1) ? 96 : 64, KST = DK + 16, NKS = DK / 32, QSPAN = NM ? 8 : 32, KB = (MODE == 1) ? KB96 : KB64;
    const int kbase = tile * 64;
    if (kbase + 127 > qw0) return false;
    if (NM && kbase + 127 >= qw0 - 127) return false;
    bool b00 = true, b01 = true, b10 = true, b11 = true, e00 = true, e01 = true, e10 = true, e11 = true;
    if (MODE == 3) { const int t1 = tile + 1;
        const unsigned wa0 = (tile < 32) ? mwA[0] : (tile < 64) ? mwA[1] : (tile < 96) ? mwA[2] : mwA[3], wb0 = (tile < 32) ? mwB[0] : (tile < 64) ? mwB[1] : (tile < 96) ? mwB[2] : mwB[3];
        const unsigned wa1 = (t1 < 32) ? mwA[0] : (t1 < 64) ? mwA[1] : (t1 < 96) ? mwA[2] : mwA[3], wb1 = (t1 < 32) ? mwB[0] : (t1 < 64) ? mwB[1] : (t1 < 96) ? mwB[2] : mwB[3];
        b00 = (wa0 >> (tile & 31)) & 1u; b10 = (wb0 >> (tile & 31)) & 1u; b01 = (wa1 >> (t1 & 31)) & 1u; b11 = (wb1 >> (t1 & 31)) & 1u;
        e00 = __builtin_amdgcn_ballot_w64(b00) != 0ull; e01 = __builtin_amdgcn_ballot_w64(b01) != 0ull; e10 = __builtin_amdgcn_ballot_w64(b10) != 0ull; e11 = __builtin_amdgcn_ballot_w64(b11) != 0ull;
        if (!(e00 || e01 || e10 || e11)) return true; }
    const bf16* Ks0 = (const bf16*)(smem + OFF_RING + cur * KB); const bf16* Ks1 = Ks0 + KB / 2;
    const bf16* Vs0 = (const bf16*)(smem + OFF_RING + 4 * KB + cur * VBUF); const bf16* Vs1 = Vs0 + VBUF / 2;
    f32x4 sc[2][8];
#pragma unroll
    for (int qt = 0; qt < 2; ++qt)
#pragma unroll
        for (int k8 = 0; k8 < 8; ++k8) sc[qt][k8] = (f32x4){0.f, 0.f, 0.f, 0.f};
#define QK_PART(qt_, t_, Ks_) do { _Pragma("unroll") for (int ks = 0; ks < NKS; ++ks) _Pragma("unroll") for (int kt = 0; kt < 4; ++kt) { \
            const bf16x8 kf = *(const bf16x8*)((Ks_) + (kt * 16 + l15) * KST + ks * 32 + quad * 8); sc[qt_][(t_) * 4 + kt] = __builtin_amdgcn_mfma_f32_16x16x32_bf16(kf, qf[qt_][ks], sc[qt_][(t_) * 4 + kt], 0, 0, 0); } } while (0)
    __builtin_amdgcn_s_setprio(1);
    if (MODE == 1 || (e00 && e10)) {
#pragma unroll
        for (int ks = 0; ks < NKS; ++ks)
#pragma unroll
            for (int kt = 0; kt < 4; ++kt) { const bf16x8 kf = *(const bf16x8*)(Ks0 + (kt * 16 + l15) * KST + ks * 32 + quad * 8);
                sc[0][kt] = __builtin_amdgcn_mfma_f32_16x16x32_bf16(kf, qf[0][ks], sc[0][kt], 0, 0, 0); sc[1][kt] = __builtin_amdgcn_mfma_f32_16x16x32_bf16(kf, qf[1][ks], sc[1][kt], 0, 0, 0); }
    } else { if (e00) QK_PART(0, 0, Ks0); if (e10) QK_PART(1, 0, Ks0); }
    if (MODE == 1 || (e01 && e11)) {
#pragma unroll
        for (int ks = 0; ks < NKS; ++ks)
#pragma unroll
            for (int kt = 0; kt < 4; ++kt) { const bf16x8 kf = *(const bf16x8*)(Ks1 + (kt * 16 + l15) * KST + ks * 32 + quad * 8);
                sc[0][4 + kt] = __builtin_amdgcn_mfma_f32_16x16x32_bf16(kf, qf[0][ks], sc[0][4 + kt], 0, 0, 0); sc[1][4 + kt] = __builtin_amdgcn_mfma_f32_16x16x32_bf16(kf, qf[1][ks], sc[1][4 + kt], 0, 0, 0); }
    } else { if (e01) QK_PART(0, 1, Ks1); if (e11) QK_PART(1, 1, Ks1); }
    __builtin_amdgcn_s_setprio(0);
#undef QK_PART
    unsigned pb[2][8][2];
#pragma unroll
    for (int qt = 0; qt < 2; ++qt) {
        const bool en0 = qt ? e10 : e00, en1 = qt ? e11 : e01;
        if (MODE == 3 && !(en0 || en1)) continue;
        float bq0 = 0.f, bq1 = 0.f;
        if (MODE == 3) { bq0 = (qt ? b10 : b00) ? c31 : -INFINITY; bq1 = (qt ? b11 : b01) ? c31 : -INFINITY; }
        float mx0 = -INFINITY, mx1 = -INFINITY;
#pragma unroll
        for (int kt = 0; kt < 4; ++kt) { mx0 = fmaxf(fmaxf(mx0, fmaxf(sc[qt][kt][0], sc[qt][kt][1])), fmaxf(sc[qt][kt][2], sc[qt][kt][3]));
                                           mx1 = fmaxf(fmaxf(mx1, fmaxf(sc[qt][4 + kt][0], sc[qt][4 + kt][1])), fmaxf(sc[qt][4 + kt][2], sc[qt][4 + kt][3])); }
        float xm = fmaxf(__builtin_fmaf(mx0, SL, bq0), __builtin_fmaf(mx1, SL, bq1));
        if (MODE == 3) { if (!en0) xm = __builtin_fmaf(mx1, SL, bq1); if (!en1) xm = __builtin_fmaf(mx0, SL, bq0); }
        xm = xrow16_max(xm);
        const float mn = fmaxf(m[qt], xm), ms = (mn == -INFINITY) ? 0.f : mn;
        const float alpha = __builtin_amdgcn_exp2f(m[qt] - ms); m[qt] = mn;
        const float off0 = (MODE == 3 && !en0) ? -INFINITY : bq0 - ms, off1 = (MODE == 3 && !en1) ? -INFINITY : bq1 - ms; float rsum = 0.f;
#pragma unroll
        for (int k8 = 0; k8 < 8; ++k8) { const float off = k8 < 4 ? off0 : off1; const bool en = k8 < 4 ? en0 : en1; float e0 = 0.f, e1 = 0.f, e2 = 0.f, e3 = 0.f;
            if (MODE == 1 || en) { e0 = __builtin_amdgcn_exp2f(__builtin_fmaf(sc[qt][k8][0], SL, off)); e1 = __builtin_amdgcn_exp2f(__builtin_fmaf(sc[qt][k8][1], SL, off));
                                   e2 = __builtin_amdgcn_exp2f(__builtin_fmaf(sc[qt][k8][2], SL, off)); e3 = __builtin_amdgcn_exp2f(__builtin_fmaf(sc[qt][k8][3], SL, off)); }
            rsum += (e0 + e1) + (e2 + e3); pb[qt][k8][0] = pk2(e0, e1); pb[qt][k8][1] = pk2(e2, e3); }
        l[qt] = l[qt] * alpha + rsum;
        if (__builtin_amdgcn_ballot_w64(alpha != 1.0f) != 0ull) {
#pragma unroll
            for (int d = 0; d < 4; ++d) o[qt][d] *= alpha; }
    }
    { unsigned p0[2][4][2], p1[2][4][2];
#pragma unroll
      for (int qt = 0; qt < 2; ++qt)
#pragma unroll
          for (int kt = 0; kt < 4; ++kt) { p0[qt][kt][0] = pb[qt][kt][0]; p0[qt][kt][1] = pb[qt][kt][1]; p1[qt][kt][0] = pb[qt][4 + kt][0]; p1[qt][kt][1] = pb[qt][4 + kt][1]; }
      if (MODE == 1) { pv_tile(Vs0, p0, o, lane); pv_tile(Vs1, p1, o, lane); }
      else { if (e00 || e10) pv_tile_en(Vs0, p0, o, lane, e00, e10); if (e01 || e11) pv_tile_en(Vs1, p1, o, lane, e01, e11); } }
    return true;
}

template <int MODE, bool PRE = false>
__device__ __forceinline__ void flash_core(const AttnP& p, const FCtx& c, char* smem, const u32x4 mwA, const u32x4 mwB, f32x4 (&o)[2][4], float (&linv)[2], const u32x4 (&pre)[4]) {
    constexpr bool NM = (MODE >= 2);
    constexpr int DK = (MODE == 1) ? 96 : 64, KST = DK + 16, VST = 80, KCH = DK / 8, NKC = 64 * KCH, NKI = (NKC + 511) / 512, NKS = DK / 32, KB = (MODE == 1) ? KB96 : KB64;
    int tid_ = threadIdx.x; asm volatile("" : "+v"(tid_)); const int tid = tid_, lane = tid & 63, l15 = lane & 15, quad = lane >> 4, hl = l15 & 3;
    const int b = c.b, hkv = c.hkv, qw0 = c.qw0, hq = NM ? (hkv * 4 + hl) : c.hq;
    const int qr0 = NM ? qw0 + (l15 >> 2) : qw0 + l15, qr1 = NM ? qr0 + 4 : qr0 + 16;
    const int thi = c.qb_hi >> 6; int tlo = 0;
    if (MODE == 2) { int lo = c.qb_lo - 511; if (lo < 0) lo = 0; tlo = lo >> 6; }
    float pre8[8] = {0.f, 0.f, 0.f, 0.f, 0.f, 0.f, 0.f, 0.f};
    if (MODE == 0) { float acc_ = 0.f;
#pragma unroll
        for (int sg = 0; sg < 8; ++sg) { pre8[sg] = acc_; acc_ += p.segtot[(size_t)(b * 8 + sg) * 8 + hq]; } }
    if (MODE == 0) {
        const float cq0 = cum_at(p.cum, pre8, (size_t)b * S, c.qb_lo, hq); int t = (c.qb_lo >> 6) - 1;
        for (;;) { const int tt = t - lane; const float cv = cum_at(p.cum, pre8, (size_t)b * S, (tt >= 0 ? tt : 0) * 64 + 63, hq);
            const bool within = (tt >= 0) && (cq0 - cv >= -88.0f);
            const unsigned long long wm = __builtin_amdgcn_ballot_w64(within);
            const int k = (wm == ~0ull) ? 64 : (int)__builtin_ctzll(~wm);
            t -= k; if (k < 64 || t < 0) break; }
        tlo = t + 1; }
    const float SL = ((MODE == 1) ? 0.10206207261596577f : 0.125f) * LOG2E;
    const size_t rowb = (size_t)b * S;
    const bf16* kp = (MODE == 2) ? p.kw : p.k; const bf16* vp = (MODE == 2) ? p.vw : p.v;
    bf16x8 qf[2][NKS];
    const int qoff = (MODE == 1) ? hq * 96 : hq * 64;
#pragma unroll
    for (int ks = 0; ks < NKS; ++ks) { qf[0][ks] = *(const bf16x8*)(p.q + (rowb + qr0) * p.ldq + qoff + ks * 32 + quad * 8); qf[1][ks] = *(const bf16x8*)(p.q + (rowb + qr1) * p.ldq + qoff + ks * 32 + quad * 8); }
    float cq[2] = {0.f, 0.f}; float c31 = 0.f;
    if (MODE == 0) { cq[0] = cum_at(p.cum, pre8, rowb, qr0, hq) * LOG2E; cq[1] = cum_at(p.cum, pre8, rowb, qr1, hq) * LOG2E; }
    if (MODE >= 2) c31 = p.relb[31 * 8 + hq] * LOG2E;
    const int koff = (MODE == 1) ? hkv * 128 : hkv * 64;
    const int voff = (MODE == 1) ? hkv * 128 + 64 : koff;
    u32x4 rkA[NKI], rvA, rkB[NKI], rvB; float rcA = 0.f, rcB = 0.f;
#define FL_LOAD(S_, tile_) do { \
        _Pragma("unroll") for (int i = 0; i < NKI; ++i) { int cc = tid + i * 512; if (NKC % 512 != 0) cc = cc < NKC ? cc : cc - 256; const int key = cc / KCH, kc = cc % KCH; const size_t row = rowb + (tile_) * 64 + key; \
            const bf16* src = kp + row * p.ldk + koff + kc * 8; \
            if (MODE == 1) { const bf16* src2 = p.k2 + row * LDW1 + C_KR + (kc - 8) * 8; src = kc >= 8 ? src2 : src; } \
            rk##S_[i] = *(const u32x4*)src; } \
        { const int key = tid >> 3, vc = tid & 7; rv##S_ = *(const u32x4*)(vp + (rowb + (tile_) * 64 + key) * p.ldv + voff + vc * 8); } \
        if (MODE == 0) rc##S_ = cum_at(p.cum, pre8, rowb, (tile_) * 64 + (tid & 63), hq) * LOG2E; } while (0)
#define FL_STORE(S_, buf_) do { bf16* Kw_ = (bf16*)(smem + OFF_RING + (buf_) * KB); bf16* Vw_ = (bf16*)(smem + OFF_RING + 4 * KB + (buf_) * VBUF); \
        _Pragma("unroll") for (int i = 0; i < NKI; ++i) { const int cc = tid + i * 512; if (NKC % 512 == 0 || cc < NKC) { const int key = cc / KCH, kc = cc % KCH; *(u32x4*)(Kw_ + key * KST + kc * 8) = rk##S_[i]; } } \
        { const int key = tid >> 3, vc = tid & 7; *(u32x4*)(Vw_ + key * VST + vc * 8) = rv##S_; } \
        if (MODE == 0 && tid < 64) ((float*)(smem + OFF_CKS))[(buf_) * 64 + tid] = rc##S_; } while (0)
    float m[2] = {-INFINITY, -INFINITY}, l[2] = {0.f, 0.f};
#pragma unroll
    for (int qt = 0; qt < 2; ++qt)
#pragma unroll
        for (int d = 0; d < 4; ++d) o[qt][d] = (f32x4){0.f, 0.f, 0.f, 0.f};
    if constexpr (MODE == 1) {
#define FL_MIN(a_, b_) ((a_) < (b_) ? (a_) : (b_))
    FL_LOAD(A, tlo); FL_LOAD(B, FL_MIN(tlo + 1, thi));
    __syncthreads();
    FL_STORE(A, 0); FL_STORE(B, 1);
    FL_LOAD(A, FL_MIN(tlo + 2, thi)); FL_LOAD(B, FL_MIN(tlo + 3, thi));
    __syncthreads();
    for (int tile = tlo, st = 0; tile <= thi; tile += 2, ++st) {
        const int pb_ = (st & 1) * 2;
        if (tile + 2 <= thi) { FL_STORE(A, 2 - pb_); FL_STORE(B, 3 - pb_); }
        FL_LOAD(A, FL_MIN(tile + 4, thi)); FL_LOAD(B, FL_MIN(tile + 5, thi));
        bool done = false;
        if constexpr (MODE == 1 || MODE == 3) { if (tile + 1 <= thi) done = fl_tile2<MODE>(smem, tile, pb_, qw0, hl, l15, quad, lane, SL, c31, mwA, mwB, qf, m, l, o); }
        if (!done) {
            fl_tile<MODE>(smem, tile, pb_, qw0, qr0, qr1, hl, l15, quad, lane, SL, c31, cq, mwA, mwB, qf, m, l, o);
            if (tile + 1 <= thi) fl_tile<MODE>(smem, tile + 1, pb_ + 1, qw0, qr0, qr1, hl, l15, quad, lane, SL, c31, cq, mwA, mwB, qf, m, l, o); }
        __syncthreads();
    }
#undef FL_MIN
    } else {
#define FL_MIN(a_, b_) ((a_) < (b_) ? (a_) : (b_))
    if constexpr (PRE) { rkA[0] = pre[0]; rvA = pre[1]; rkB[0] = pre[2]; rvB = pre[3]; }
    else { FL_LOAD(A, tlo); FL_LOAD(B, FL_MIN(tlo + 1, thi)); }
    __syncthreads();
    FL_STORE(A, 0);
    FL_LOAD(A, FL_MIN(tlo + 2, thi));
    __syncthreads();
    for (int tile = tlo; tile <= thi; tile += 2) {
        if (tile + 1 <= thi) FL_STORE(B, 1);
        FL_LOAD(B, FL_MIN(tile + 3, thi));
        fl_tile<MODE>(smem, tile, 0, qw0, qr0, qr1, hl, l15, quad, lane, SL, c31, cq, mwA, mwB, qf, m, l, o);
        __syncthreads();
        if (tile + 1 > thi) break;
        if (tile + 2 <= thi) FL_STORE(A, 0);
        FL_LOAD(A, FL_MIN(tile + 4, thi));
        fl_tile<MODE>(smem, tile + 1, 1, qw0, qr0, qr1, hl, l15, quad, lane, SL, c31, cq, mwA, mwB, qf, m, l, o);
        __syncthreads();
    }
#undef FL_MIN
    }
#undef FL_LOAD
#undef FL_STORE
#pragma unroll
    for (int qt = 0; qt < 2; ++qt) { float lt = l[qt]; lt = xrow16_sum(lt); linv[qt] = 1.0f / fmaxf(lt, 1e-30f); }
}

template <int MODE>
__device__ __forceinline__ void flash_item(const AttnP& p, int item, char* smem) {
    int tid_ = threadIdx.x; asm volatile("" : "+v"(tid_)); const int lane = tid_ & 63, w = tid_ >> 6, l15 = lane & 15, quad = lane >> 4;
    FCtx c; const int nqt = S / 256; const int qt_ = nqt - 1 - item / (NB * 8), bh = item % (NB * 8);
    c.b = bh >> 3; c.hq = bh & 7; c.hkv = c.hq; c.qb_lo = qt_ * 256; c.qb_hi = c.qb_lo + 255; c.qw0 = c.qb_lo + w * 32;
    const u32x4 z = {0u, 0u, 0u, 0u}; f32x4 o[2][4]; float linv[2]; const u32x4 nopre[4] = {z, z, z, z};
    flash_core<MODE>(p, c, smem, z, z, o, linv, nopre);
#pragma unroll
    for (int qt = 0; qt < 2; ++qt) { const size_t row = (size_t)c.b * S + c.qw0 + qt * 16 + l15;
#pragma unroll
        for (int d = 0; d < 4; ++d) { const f32x4 v = o[qt][d] * linv[qt]; *(uint2*)(p.out + row * p.ldo + c.hq * 64 + d * 16 + quad * 4) = pk4(v); } }
}

__device__ __forceinline__ void cmp_core(const AttnP& p, const FCtx& c, char* smem, f32x4 (&o)[2][4], u32x4& mwA, u32x4& mwB, u32x4 (&pre)[4]) {
    constexpr int KST = 80, VST = 80;
    float* tb = (float*)(smem + OFF_TB); float* impq = (float*)(smem + OFF_IMP); float* imps = impq + 64 * IMPS; unsigned* selw = (unsigned*)(smem + OFF_SELW);
    int tid_ = threadIdx.x; asm volatile("" : "+v"(tid_)); const int tid = tid_, lane = tid & 63, w = tid >> 6, l15 = lane & 15, quad = lane >> 4, hl = l15 & 3;
    const int qw0 = c.qw0, bg = c.b * 2 + c.hkv, hq = c.hkv * 4 + hl, qr0 = qw0 + (l15 >> 2), qr1 = qr0 + 4;
    const size_t rowb = (size_t)c.b * S;
    const int nk = (c.qb_lo + 32) / 16 + 1, ntile = (nk + 63) >> 6;
    const float SL = 0.125f * LOG2E; const float c31 = p.relb[31 * 8 + hq] * LOG2E;
    bf16x8 qf[2][2];
#pragma unroll
    for (int ks = 0; ks < 2; ++ks) { qf[0][ks] = *(const bf16x8*)(p.q + (rowb + qr0) * p.ldq + hq * 64 + ks * 32 + quad * 8); qf[1][ks] = *(const bf16x8*)(p.q + (rowb + qr1) * p.ldq + hq * 64 + ks * 32 + quad * 8); }
    const bf16* kb = p.kcb + (size_t)bg * 512 * 64; const bf16* vb = p.vcb + (size_t)bg * 512 * 64;
    u32x4 rk, rv;
#define CM_LOAD(tile_) do { const int key = tid >> 3, kc = tid & 7; rk = *(const u32x4*)(kb + (size_t)((tile_) * 64 + key) * 64 + kc * 8); rv = *(const u32x4*)(vb + (size_t)((tile_) * 64 + key) * 64 + kc * 8); } while (0)
#define CM_STORE(buf_) do { const int key = tid >> 3, kc = tid & 7; *(u32x4*)((bf16*)(smem + OFF_RING + (buf_) * KB64) + key * KST + kc * 8) = rk; *(u32x4*)((bf16*)(smem + OFF_RING + 4 * KB64 + (buf_) * VBUF) + key * VST + kc * 8) = rv; } while (0)
#define CM_SCORE(tile_) do { qk_tile<2, KST>(Ks, qf, sc, l15, quad); \
        if (qw0 - (16 * ((tile_) * 64 + 63) + 31) >= 128) {            \
            _Pragma("unroll") for (int qt = 0; qt < 2; ++qt) _Pragma("unroll") for (int kt = 0; kt < 4; ++kt) _Pragma("unroll") for (int r = 0; r < 4; ++r) sc[qt][kt][r] = __builtin_fmaf(sc[qt][kt][r], SL, c31); \
        } else \
        _Pragma("unroll") for (int qt = 0; qt < 2; ++qt) { const int q = qt ? qr1 : qr0; \
            _Pragma("unroll") for (int kt = 0; kt < 4; ++kt) _Pragma("unroll") for (int r = 0; r < 4; ++r) { const int ci = (tile_) * 64 + kt * 16 + quad * 4 + r; const int dd = q - (16 * ci + 31); \
                const int di = dd < 0 ? 0 : (dd > 127 ? 127 : dd); const float tv = tb[hl * 136 + di]; const float bs = dd < 128 ? tv : c31; \
                sc[qt][kt][r] = (dd >= 0) ? __builtin_fmaf(sc[qt][kt][r], SL, bs) : -INFINITY; } } } while (0)
    float m[2] = {-INFINITY, -INFINITY}, l[2] = {0.f, 0.f};
    float ms2[2] = {0.f, 0.f}, il[2] = {0.f, 0.f};
#pragma unroll
    for (int qt = 0; qt < 2; ++qt)
#pragma unroll
        for (int d = 0; d < 4; ++d) o[qt][d] = (f32x4){0.f, 0.f, 0.f, 0.f};
    for (int pass = 0; pass < 2; ++pass) {
        CM_LOAD(0);
        __syncthreads();
        CM_STORE(0);
        if (ntile > 1) CM_LOAD(1);
        __syncthreads();
        for (int tile = 0; tile < ntile; ++tile) {
            const int cur = tile & 1;
            if (tile + 1 < ntile) { CM_STORE(cur ^ 1); if (tile + 2 < ntile) CM_LOAD(tile + 2); }
            if (tile * 64 * 16 + 31 <= qw0 + 7) {
                const bf16* Ks = (const bf16*)(smem + OFF_RING + cur * KB64); const bf16* Vs = (const bf16*)(smem + OFF_RING + 4 * KB64 + cur * VBUF);
                f32x4 sc[2][4]; CM_SCORE(tile);
                if (pass == 0) {
#pragma unroll
                    for (int qt = 0; qt < 2; ++qt) { float mx = -INFINITY;
#pragma unroll
                        for (int kt = 0; kt < 4; ++kt) mx = fmaxf(fmaxf(mx, fmaxf(sc[qt][kt][0], sc[qt][kt][1])), fmaxf(sc[qt][kt][2], sc[qt][kt][3]));
                        mx = xrow16_max(mx);
                        const float mn = fmaxf(m[qt], mx), ms = (mn == -INFINITY) ? 0.f : mn; const float alpha = __builtin_amdgcn_exp2f(m[qt] - ms); m[qt] = mn; float rsum = 0.f;
#pragma unroll
                        for (int kt = 0; kt < 4; ++kt)
#pragma unroll
                            for (int r = 0; r < 4; ++r) rsum += __builtin_amdgcn_exp2f(sc[qt][kt][r] - ms);
                        l[qt] = l[qt] * alpha + rsum; }
                } else {
                    unsigned pb[2][4][2];
#pragma unroll
                    for (int qt = 0; qt < 2; ++qt) { const int ql = w * 8 + qt * 4 + (l15 >> 2);
#pragma unroll
                        for (int kt = 0; kt < 4; ++kt) { const float e0 = __builtin_amdgcn_exp2f(sc[qt][kt][0] - ms2[qt]) * il[qt], e1 = __builtin_amdgcn_exp2f(sc[qt][kt][1] - ms2[qt]) * il[qt],
                                                               e2 = __builtin_amdgcn_exp2f(sc[qt][kt][2] - ms2[qt]) * il[qt], e3 = __builtin_amdgcn_exp2f(sc[qt][kt][3] - ms2[qt]) * il[qt];
                            pb[qt][kt][0] = pk2(e0, e1); pb[qt][kt][1] = pk2(e2, e3);
                            float qs = (e0 + e1) + (e2 + e3), es = e3;
                            qs += dppf<DPP_XOR1>(qs); qs += dppf<DPP_XOR2>(qs); es += dppf<DPP_XOR1>(es); es += dppf<DPP_XOR2>(es);
                            const int j = tile * 16 + kt * 4 + quad;
                            if (hl == 0) { impq[ql * IMPS + j] = qs; if (j + 1 < 128) imps[ql * IMPS + j + 1] = es; } } }
                    pv_tile(Vs, pb, o, lane);
                }
            }
            __syncthreads();
        }
        if (pass == 0) {
#pragma unroll
            for (int qt = 0; qt < 2; ++qt) { const float lt = xrow16_sum(l[qt]); il[qt] = 1.0f / fmaxf(lt, 1e-30f); ms2[qt] = (m[qt] == -INFINITY) ? 0.f : m[qt]; } }
    }
#undef CM_LOAD
#undef CM_STORE
#undef CM_SCORE
    {
        const int key = tid >> 3, kc = tid & 7, t1 = (c.qb_hi >> 6) >= 1 ? 1 : 0;
        pre[0] = *(const u32x4*)(p.k + (rowb + key) * p.ldk + c.hkv * 64 + kc * 8); pre[1] = *(const u32x4*)(p.v + (rowb + key) * p.ldv + c.hkv * 64 + kc * 8);
        pre[2] = *(const u32x4*)(p.k + (rowb + t1 * 64 + key) * p.ldk + c.hkv * 64 + kc * 8); pre[3] = *(const u32x4*)(p.v + (rowb + t1 * 64 + key) * p.ldv + c.hkv * 64 + kc * 8); }
    {
        const int qy = tid >> 3, sub = tid & 7, cur = c.qb_lo >> 6;
        unsigned m0 = 1u, m1 = 0u, m2 = 0u, m3 = 0u;
#define SETBIT(j_) do { const int jj_ = (j_); const unsigned bb_ = 1u << (jj_ & 31); const int wi_ = jj_ >> 5; m0 |= wi_ == 0 ? bb_ : 0u; m1 |= wi_ == 1 ? bb_ : 0u; m2 |= wi_ == 2 ? bb_ : 0u; m3 |= wi_ == 3 ? bb_ : 0u; } while (0)
        if (cur <= 15) { m0 = (1u << (cur + 1)) - 1u; }
        else {
            SETBIT(cur); SETBIT(cur - 1);
            float v[16];
#pragma unroll
            for (int i = 0; i < 16; ++i) { const int j = sub + 8 * i; v[i] = (j >= 1 && j <= cur - 2) ? impq[qy * IMPS + j] + imps[qy * IMPS + j] : -INFINITY; }
            for (int it = 0; it < 13; ++it) { float bv = -INFINITY; int bj = 1 << 20;
#pragma unroll
                for (int i = 0; i < 16; ++i) { if (v[i] > bv) { bv = v[i]; bj = sub + 8 * i; } }
                { const float ov = dppf<DPP_XOR1>(bv); const int oj = dppi<DPP_XOR1>(bj); if (ov > bv || (ov == bv && oj < bj)) { bv = ov; bj = oj; } }
                { const float ov = dppf<DPP_XOR2>(bv); const int oj = dppi<DPP_XOR2>(bj); if (ov > bv || (ov == bv && oj < bj)) { bv = ov; bj = oj; } }
                { const float ov = dppf<DPP_HMIRROR>(bv); const int oj = dppi<DPP_HMIRROR>(bj); if (ov > bv || (ov == bv && oj < bj)) { bv = ov; bj = oj; } }
                SETBIT(bj);
#pragma unroll
                for (int i = 0; i < 16; ++i) v[i] = (sub + 8 * i == bj) ? -INFINITY : v[i]; }
        }
#undef SETBIT
        if (sub == 0) *(u32x4*)(selw + qy * 4) = (u32x4){m0, m1, m2, m3};
    }
    __syncthreads();
    mwA = *(const u32x4*)(selw + (w * 8 + (l15 >> 2)) * 4); mwB = *(const u32x4*)(selw + (w * 8 + 4 + (l15 >> 2)) * 4);
    __syncthreads();
}

__device__ __forceinline__ void nsa_item(const AttnP& p, int item, char* smem) {
    int tid_ = threadIdx.x; asm volatile("" : "+v"(tid_)); const int tid = tid_, lane = tid & 63, w = tid >> 6, l15 = lane & 15, quad = lane >> 4, hl = l15 & 3;
    FCtx c; const int nqt = S / 64; const int qt_ = nqt - 1 - item / (NB * 2), bg = item % (NB * 2);
    c.b = bg >> 1; c.hkv = bg & 1; c.hq = c.hkv * 4; c.qb_lo = qt_ * 64; c.qb_hi = c.qb_lo + 63; c.qw0 = c.qb_lo + 8 * w;
    const int hq = c.hkv * 4 + hl; const size_t row0 = (size_t)c.b * S + c.qw0 + (l15 >> 2), row1 = row0 + 4;
    float* tb = (float*)(smem + OFF_TB); float* ys = (float*)(smem + OFF_Y) + w * 32 * YST;
    tb[(tid >> 7) * 136 + (tid & 127)] = p.tbg[(c.hkv * 4 + (tid >> 7)) * 128 + (tid & 127)];
    u32x4 mwA, mwB; f32x4 o[2][4]; float linv[2]; u32x4 pre[4];
    bf16 glr[2][3]; float bg3[3];
#pragma unroll
    for (int j = 0; j < 3; ++j) { glr[0][j] = p.gl[row0 * LDW1 + C_GL + hq * 3 + j]; glr[1][j] = p.gl[row1 * LDW1 + C_GL + hq * 3 + j]; bg3[j] = p.bgate[hq * 3 + j]; }
    cmp_core(p, c, smem, o, mwA, mwB, pre);
#pragma unroll
    for (int qt = 0; qt < 2; ++qt) { const float g0 = sigmoidf_(bf2f(glr[qt][0]) + bg3[0]);
#pragma unroll
        for (int d = 0; d < 4; ++d) *(f32x4*)(ys + (qt * 16 + l15) * YST + d * 16 + quad * 4) = o[qt][d] * g0; }
    flash_core<3, true>(p, c, smem, mwA, mwB, o, linv, pre);
#pragma unroll
    for (int qt = 0; qt < 2; ++qt) { const float g1 = sigmoidf_(bf2f(glr[qt][1]) + bg3[1]) * linv[qt];
#pragma unroll
        for (int d = 0; d < 4; ++d) { f32x4* yp = (f32x4*)(ys + (qt * 16 + l15) * YST + d * 16 + quad * 4); *yp = *yp + o[qt][d] * g1; } }
    flash_core<2>(p, c, smem, mwA, mwB, o, linv, pre);
#pragma unroll
    for (int qt = 0; qt < 2; ++qt) { const size_t row = qt ? row1 : row0; const float g2 = sigmoidf_(bf2f(glr[qt][2]) + bg3[2]) * linv[qt];
#pragma unroll
        for (int d = 0; d < 4; ++d) { const f32x4 v = *(const f32x4*)(ys + (qt * 16 + l15) * YST + d * 16 + quad * 4) + o[qt][d] * g2; *(uint2*)(p.out + row * p.ldo + hq * 64 + d * 16 + quad * 4) = pk4(v); } }
}

typedef float f32x16 __attribute__((ext_vector_type(16)));
struct S5P { const bf16* u0; const float *lre, *lim, *ldt, *bre, *bim, *cre, *cim, *dsk; float* E; bf16* hg; };
constexpr int S5_L = 128, S5_NC = S / S5_L, S5_XST = 144, S5_SMEM = 8 * 32 * S5_XST * 2;
template <bool PASSB>
__device__ __forceinline__ void s5_item(const S5P& p, int item, char* smem) {
    int tid_ = threadIdx.x; asm volatile("" : "+v"(tid_)); const int tid = tid_, lane = tid & 63, w = tid >> 6, l15 = lane & 15, quad = lane >> 4, p31 = lane & 31, hf = lane >> 5;
    const int wv = item * 8 + w, bg = wv >> 5, pair = wv & 31, b = bg >> 5, g = bg & 31, chunk = pair * 2 + hf;
    bf16* Xs = (bf16*)smem + w * 32 * S5_XST;
    const float dt = __expf(p.ldt[g]);
    float ar[2], ai[2]; bf16x8 bbf[4];
#pragma unroll
    for (int st = 0; st < 2; ++st) { const int sidx = g * 64 + st * 32 + p31; const float lr = p.lre[sidx], li = p.lim[sidx];
        const float mag = __expf(lr * dt); ar[st] = mag * cosf(li * dt); ai[st] = mag * sinf(li * dt);
        const float den = lr * lr + li * li, nr = ar[st] - 1.0f, ni = ai[st]; const float fr = (nr * lr + ni * li) / den, fi = (ni * lr - nr * li) / den;
        const f32x4 b0 = *(const f32x4*)(p.bre + (size_t)sidx * 16 + 8 * hf), b1 = *(const f32x4*)(p.bre + (size_t)sidx * 16 + 8 * hf + 4);
        const f32x4 i0 = *(const f32x4*)(p.bim + (size_t)sidx * 16 + 8 * hf), i1 = *(const f32x4*)(p.bim + (size_t)sidx * 16 + 8 * hf + 4);
        const f32x4 r0 = b0 * fr - i0 * fi, r1 = b1 * fr - i1 * fi, m0 = i0 * fr + b0 * fi, m1 = i1 * fr + b1 * fi;
        const u32x4 tr = {pk2(r0[0], r0[1]), pk2(r0[2], r0[3]), pk2(r1[0], r1[1]), pk2(r1[2], r1[3])}, ti = {pk2(m0[0], m0[1]), pk2(m0[2], m0[3]), pk2(m1[0], m1[1]), pk2(m1[2], m1[3])};
        bbf[2 * st] = __builtin_bit_cast(bf16x8, tr); bbf[2 * st + 1] = __builtin_bit_cast(bf16x8, ti); }
    float sr[2] = {0.f, 0.f}, si[2] = {0.f, 0.f};
    bf16x8 cf[4];
    if (PASSB) {
#pragma unroll
        for (int st = 0; st < 2; ++st) { float pr = ar[st], pi = ai[st];
#pragma unroll
            for (int i = 0; i < 7; ++i) { const float t = pr * pr - pi * pi; pi = 2.f * pr * pi; pr = t; }
            const float* ep = p.E + ((size_t)bg * S5_NC * 64 + st * 32 + p31) * 2; float xr = 0.f, xi = 0.f;
#pragma unroll 8
            for (int cpr = 0; cpr < chunk; ++cpr) { const float2 e = *(const float2*)(ep + (size_t)cpr * 128); const float t = pr * xr - pi * xi + e.x; xi = pr * xi + pi * xr + e.y; xr = t; }
            sr[st] = xr; si[st] = xi; }
#pragma unroll
        for (int ks = 0; ks < 4; ++ks)
#pragma unroll
            for (int j = 0; j < 8; ++j) { const int k = ks * 32 + quad * 8 + j, st = k >> 1; const float v = (k & 1) ? -p.cim[(g * 16 + l15) * 64 + st] : p.cre[(g * 16 + l15) * 64 + st]; cf[ks][j] = (short)f2bf(v); }
    }
    const int arow_half = (p31 >> 2) & 1, arow_r = (p31 & 3) + 4 * (p31 >> 3);
    const bf16* ua = p.u0 + ((size_t)b * S + (size_t)(pair * 2 + arow_half) * S5_L + arow_r) * 512 + g * 16 + 8 * hf;
    const f32x4 dv = *(const f32x4*)(p.dsk + g * 16 + quad * 4);
    bf16x8 af = *(const bf16x8*)ua;
    for (int rd = 0; rd < S5_L / 16; ++rd) {
        const int rdn = rd + 1 < S5_L / 16 ? rd + 1 : rd;
        const bf16x8 afn = *(const bf16x8*)(ua + (size_t)rdn * 16 * 512);
        uint2 uwv[2];
        if (PASSB) {
#pragma unroll
            for (int tile = 0; tile < 2; ++tile) uwv[tile] = *(const uint2*)(p.u0 + ((size_t)b * S + (size_t)(pair * 2 + tile) * S5_L + rd * 16 + l15) * 512 + g * 16 + quad * 4); }
        f32x16 bu[4];
#pragma unroll
        for (int ct = 0; ct < 4; ++ct) { f32x16 z;
#pragma unroll
            for (int i = 0; i < 16; ++i) z[i] = 0.f;
            bu[ct] = __builtin_amdgcn_mfma_f32_32x32x16_bf16(af, bbf[ct], z, 0, 0, 0); }
#pragma unroll
        for (int r = 0; r < 16; ++r)
#pragma unroll
            for (int st = 0; st < 2; ++st) { const float nsr = ar[st] * sr[st] - ai[st] * si[st] + bu[2 * st][r], nsi = ar[st] * si[st] + ai[st] * sr[st] + bu[2 * st + 1][r]; sr[st] = nsr; si[st] = nsi;
                if (PASSB) *(unsigned*)(Xs + (hf * 16 + r) * S5_XST + 2 * (st * 32 + p31)) = pk2(nsr, nsi); }
        if (PASSB) {
            __syncthreads();
#pragma unroll
            for (int tile = 0; tile < 2; ++tile) { f32x4 acc = {0.f, 0.f, 0.f, 0.f};
#pragma unroll
                for (int ks = 0; ks < 4; ++ks) { const bf16x8 xf = *(const bf16x8*)(Xs + (tile * 16 + l15) * S5_XST + ks * 32 + quad * 8); acc = __builtin_amdgcn_mfma_f32_16x16x32_bf16(cf[ks], xf, acc, 0, 0, 0); }
                const size_t row = (size_t)b * S + (size_t)(pair * 2 + tile) * S5_L + rd * 16 + l15; const int ch = g * 16 + quad * 4;
                const uint2 uw = uwv[tile]; const f32x4 uv = {__uint_as_float(uw.x << 16), __uint_as_float(uw.x & 0xffff0000u), __uint_as_float(uw.y << 16), __uint_as_float(uw.y & 0xffff0000u)};
                const f32x4 yv = acc + dv * uv;
                *(uint2*)(p.hg + row * 512 + ch) = make_uint2(pk2(gelu_tanh(yv[0]), gelu_tanh(yv[1])), pk2(gelu_tanh(yv[2]), gelu_tanh(yv[3]))); }
            __syncthreads();
        }
        af = afn;
    }
    if (!PASSB) {
#pragma unroll
        for (int st = 0; st < 2; ++st) *(float2*)(p.E + (((size_t)bg * S5_NC + chunk) * 64 + st * 32 + p31) * 2) = make_float2(sr[st], si[st]); }
}

template <int MODE>
__device__ __forceinline__ const float* cvt_col(const float* W, const float* W2, int n) {
    if (MODE == 1) { const int pn = n >> 8, bj = (n >> 7) & 1, cc = n & 127; return (bj ? W2 : W) + pn * 128 + cc; }
    if (MODE == 2) { const int hh = n / 96, cc = n - hh * 96; if (cc < 64) return W + n; const int r = cc - 64; return W + hh * 96 + 64 + (r & 1) * 16 + (r >> 1); }
    if (MODE == 3) { if (n >= C_KR && n < C_KR + 32) { const int r = n - C_KR; return W + C_KR + (r & 1) * 16 + (r >> 1); } return W + n; }
    if (MODE == 4) return W + (n & 127) + (size_t)(n >> 7) * 1024 * 128;
    return W + n;
}
template <int MODE, bool HASGAIN>
__device__ __forceinline__ void cvt_all(const float* W, const float* W2, int ldw, const float* gain, bf16* dst, int N, int Nsrc, int K, char* smem, int bid, int G) {
    constexpr int TST = 132; bf16* t = (bf16*)smem;
    const int nT = N / 64, nt = nT * (K / 128);
    int tid_ = threadIdx.x; asm volatile("" : "+v"(tid_)); const int tid = tid_, n = tid & 63, kq = tid >> 6;
    float v[16];
#define CV_LOAD(tile_) do { const int tn_ = (tile_) % nT, tk_ = (tile_) / nT, ng_ = tn_ * 64 + n; const bool ok_ = ng_ < Nsrc; const float* col_ = cvt_col<MODE>(W, W2, ok_ ? ng_ : 0); \
        _Pragma("unroll") for (int i = 0; i < 8; ++i) { const int k_ = tk_ * 128 + i * 16 + kq * 2; float a_ = col_[(size_t)k_ * ldw], b_ = col_[(size_t)(k_ + 1) * ldw]; \
            if (HASGAIN) { a_ *= gain[k_]; b_ *= gain[k_ + 1]; } v[2 * i] = ok_ ? a_ : 0.f; v[2 * i + 1] = ok_ ? b_ : 0.f; } } while (0)
    int tile = bid;
    if (tile < nt) CV_LOAD(tile);
    for (; tile < nt; tile += G) {
        const int tn = tile % nT, tk = tile / nT;
        __syncthreads();
#pragma unroll
        for (int i = 0; i < 8; ++i) *(unsigned*)(t + n * TST + i * 16 + kq * 2) = pk2(v[2 * i], v[2 * i + 1]);
        __syncthreads();
        if (tile + G < nt) CV_LOAD(tile + G);
        { const int nn = tid >> 3, kc = tid & 7; const bf16* src = t + nn * TST + kc * 16;
          const u32x2 a0 = *(const u32x2*)src, a1 = *(const u32x2*)(src + 4), a2 = *(const u32x2*)(src + 8), a3 = *(const u32x2*)(src + 12);
          bf16* d = dst + (size_t)(tn * 64 + nn) * K + tk * 128 + kc * 16;
          *(u32x4*)d = (u32x4){a0[0], a0[1], a1[0], a1[1]}; *(u32x4*)(d + 8) = (u32x4){a2[0], a2[1], a3[0], a3[1]}; }
    }
#undef CV_LOAD
    __syncthreads();
}

__device__ __forceinline__ void foxcum_block(const float* flog, const float* bf, float* cum, float* segtot, int item, char* smem) {
    int tid_ = threadIdx.x; asm volatile("" : "+v"(tid_)); const int tid = tid_, lane = tid & 63, w = tid >> 6;
    const int b = item >> 3, seg = item & 7;
    const f32x4 bf0 = *(const f32x4*)bf, bf1 = *(const f32x4*)(bf + 4);
    const size_t r0 = ((size_t)b * S + (size_t)seg * 1024 + (size_t)tid * 2) * 8;
    float a[2][8];
#pragma unroll
    for (int i = 0; i < 2; ++i) { const f32x4 x0 = *(const f32x4*)(flog + r0 + i * 8) + bf0, x1 = *(const f32x4*)(flog + r0 + i * 8 + 4) + bf1;
#pragma unroll
        for (int h = 0; h < 4; ++h) { a[i][h] = log_sigmoid(x0[h]); a[i][4 + h] = log_sigmoid(x1[h]); } }
    double* wt = (double*)smem;
    double run[8];
    __syncthreads();
#pragma unroll
    for (int h = 0; h < 8; ++h) { const double sloc = (double)a[0][h] + (double)a[1][h]; double incl = sloc;
        for (int o = 1; o < 64; o <<= 1) { const double v = __shfl_up(incl, o); if (lane >= o) incl += v; }
        run[h] = incl - sloc; if (lane == 63) wt[w * 8 + h] = incl; }
    __syncthreads();
#pragma unroll
    for (int h = 0; h < 8; ++h) { double pre = 0.0, tot = 0.0; for (int ww = 0; ww < 8; ++ww) { const double v = wt[ww * 8 + h]; pre += ww < w ? v : 0.0; tot += v; } run[h] += pre;
        if (tid == 0) segtot[(size_t)(b * 8 + seg) * 8 + h] = (float)tot; }
#pragma unroll
    for (int i = 0; i < 2; ++i) { f32x4 o0, o1;
#pragma unroll
        for (int h = 0; h < 4; ++h) { run[h] += (double)a[i][h]; run[4 + h] += (double)a[i][4 + h]; o0[h] = (float)run[h]; o1[h] = (float)run[4 + h]; }
        *(f32x4*)(cum + r0 + i * 8) = o0; *(f32x4*)(cum + r0 + i * 8 + 4) = o1; }
}

#define XB_TMO      128
#define XB_XCNT(j)  (256  + 64 * (j))
#define XB_XSUB(j)  (1280 + 64 * (j))
#define XB_XGEN(j)  (2304 + 64 * (j))
#define XB_TOP      3328
#define XB_TOPGEN   3392
#define XCD_BAR_WORDS 3456
#define XB_SPIN_CAP (1u << 22)
__device__ __forceinline__ unsigned xb_ld(unsigned* p)              { return __hip_atomic_load(p, __ATOMIC_RELAXED, __HIP_MEMORY_SCOPE_AGENT); }
__device__ __forceinline__ unsigned xb_add(unsigned* p, unsigned v) { return __hip_atomic_fetch_add(p, v, __ATOMIC_RELAXED, __HIP_MEMORY_SCOPE_AGENT); }
__device__ __forceinline__ unsigned xb_xcc_id() { return (unsigned)__builtin_amdgcn_s_getreg((3 << 11) | 20) & 0xFu; }
#define XB_SPIN(cond, bar) do { unsigned _sp = 0; while (cond) { __builtin_amdgcn_s_sleep(1); \
    if ((++_sp & 255u) == 0u) { if (xb_ld(&(bar)[XB_TMO])) break; if (_sp > XB_SPIN_CAP) { atomicAdd(&(bar)[XB_TMO], 1u); break; } } } } while (0)
struct XcdBarrier { unsigned* bar; unsigned x; volatile LDS_AS unsigned* st; };
__device__ __forceinline__ XcdBarrier xcd_barrier_post(unsigned* bar, volatile LDS_AS unsigned* st) {
    XcdBarrier b; b.bar = bar; b.x = xb_xcc_id(); b.st = st;
    if (threadIdx.x == 0) (void)xb_add(&bar[XB_XCNT(b.x)], 1u);
    return b;
}
__device__ __forceinline__ void xcd_barrier_complete(unsigned* bar, unsigned x, unsigned& nloc, unsigned& nx) {
    const unsigned G = gridDim.x * gridDim.y * gridDim.z;
    unsigned sum, cnt, mine, sp = 0u;
    for (;;) {
        sum = 0u; cnt = 0u; mine = 0u;
#pragma unroll
        for (unsigned j = 0; j < 16; ++j) { const unsigned c = xb_ld(&bar[XB_XCNT(j)]); sum += c; cnt += (c > 0u) ? 1u : 0u; mine = (j == x) ? c : mine; }
        if (sum == G) break;
        __builtin_amdgcn_s_sleep(1);
        if ((++sp & 255u) == 0u) { if (xb_ld(&bar[XB_TMO])) break; if (sp > XB_SPIN_CAP) { atomicAdd(&bar[XB_TMO], 1u); break; } }
    }
    nloc = mine > 0u ? mine : 1u; nx = cnt > 0u ? cnt : 1u;
}
__device__ __forceinline__ void xcd_barrier(const XcdBarrier& b) {
    asm volatile("s_waitcnt vmcnt(0)" ::: "memory");
    __syncthreads();
    if (threadIdx.x == 0) {
        unsigned* bar = b.bar;
        __builtin_amdgcn_s_waitcnt(0);
        unsigned nloc = b.st[0], nx = b.st[1];
        if (nloc == 0u) { xcd_barrier_complete(bar, b.x, nloc, nx); b.st[0] = nloc; b.st[1] = nx; }
        const unsigned old = xb_add(&bar[XB_XSUB(b.x)], 1u);
        const unsigned gen = old / nloc;
        if (old + 1u == (gen + 1u) * nloc) {
            __builtin_amdgcn_fence(__ATOMIC_RELEASE, "agent");
            asm volatile("s_waitcnt vmcnt(0)" ::: "memory");
            const unsigned og = xb_add(&bar[XB_TOP], 1u);
            const unsigned tg = og / nx;
            if (og + 1u == (tg + 1u) * nx) xb_add(&bar[XB_TOPGEN], 1u);
            else XB_SPIN(xb_ld(&bar[XB_TOPGEN]) == tg, bar);
            __builtin_amdgcn_fence(__ATOMIC_ACQUIRE, "agent");
            xb_add(&bar[XB_XGEN(b.x)], 1u);
            asm volatile("s_waitcnt vmcnt(0)" ::: "memory");
        } else {
            XB_SPIN(xb_ld(&bar[XB_XGEN(b.x)]) == gen, bar);
            __builtin_amdgcn_fence(__ATOMIC_ACQUIRE, "agent");
            asm volatile("s_waitcnt vmcnt(0)" ::: "memory");
        }
    }
    __syncthreads();
}

#define GB_BASE     (XCD_BAR_WORDS + 64 * 64)
#define GB_CNT(j)   (GB_BASE + 64 * (j))
#define GB_GEN(j)   (GB_BASE + 512 + 64 * (j))
#define GB_MASK(j)  (GB_BASE + 1024 + 64 * (j))
#define GB_WORDS    1536
#define NSA_Q       (GB_BASE + GB_WORDS)
#define Q_WORDS     64
__device__ __forceinline__ void grp_barrier(const XcdBarrier& b) {
    asm volatile("s_waitcnt vmcnt(0)" ::: "memory");
    __syncthreads();
    if (threadIdx.x == 0) {
        unsigned* bar = b.bar; const unsigned g = blockIdx.x & 7u, G = gridDim.x, gsz = (G - 1u - g) / 8u + 1u;
        __builtin_amdgcn_s_waitcnt(0);
        const unsigned coloc = b.st[2], gen = b.st[3];
        if (!coloc) { __builtin_amdgcn_fence(__ATOMIC_RELEASE, "agent"); asm volatile("s_waitcnt vmcnt(0)" ::: "memory"); }
        const unsigned old = xb_add(&bar[GB_CNT(g)], 1u);
        if (old + 1u == (gen + 1u) * gsz) xb_add(&bar[GB_GEN(g)], 1u);
        else XB_SPIN(xb_ld(&bar[GB_GEN(g)]) == gen, bar);
        __builtin_amdgcn_fence(__ATOMIC_ACQUIRE, "agent");
        asm volatile("s_waitcnt vmcnt(0)" ::: "memory");
        b.st[3] = gen + 1u;
    }
    __syncthreads();
}

struct MegaP { const float* in[47]; WS ws; float* h; };
constexpr int MEGA_SMEM = (FL_SMEM > 131072 ? FL_SMEM : 131072);
#define FOR_ITEMS(it_, n_) for (int r_ = 0, it_ = bid; r_ * G < (n_); ++r_, it_ = r_ * G + ((r_ & 1) ? G - 1 - bid : bid)) if (it_ < (n_))

__device__ __forceinline__ void cvt_ffn(const float* gain, const float* wg, const float* wu, const float* wd, bf16* w1, bf16* w2, char* smem, int bid, int G) {
    cvt_all<1, true>(wg, wu, FF, gain, w1, 2 * FF, 2 * FF, D, smem, bid, G);
    cvt_all<0, false>(wd, nullptr, D, nullptr, w2, D, D, FF, smem, bid, G);
}
__device__ __forceinline__ void ffn_phases(const MegaP& P, const bf16* w1, const bf16* w2, char* smem, int bid, int G, const XcdBarrier& xb, int cvt_base = -1, bf16* cw1 = nullptr, bf16* cw2 = nullptr, const float* hin32 = nullptr, float* hout32 = nullptr, bool full_after = false) {
    const WS& ws = P.ws;
    big_gemm<EpiFFN1, true>(ws.hb, D, w1, T, 2 * FF, D, EpiFFN1{ws.hid, ws.ssq}, smem, G, bid);
    if (cvt_base >= 0 && bid >= G / 2) { __syncthreads(); cvt_ffn(P.in[cvt_base], P.in[cvt_base + 1], P.in[cvt_base + 2], P.in[cvt_base + 3], cw1, cw2, smem, bid - G / 2, G - G / 2); }
    grp_barrier(xb);
    if (hout32) { res_gemm(ws.hid, FF, w2, FF, EpiRes{nullptr, hout32, ws.hb, ws.ssq, P.in[46], ws.bar + XCD_BAR_WORDS, 0.5f, 0}, smem, G, bid); return; }
    res_gemm(ws.hid, FF, w2, FF, EpiRes{hin32, nullptr, ws.hb, ws.ssq, nullptr, nullptr, 0.5f, 0}, smem, G, bid);
    if (full_after) xcd_barrier(xb); else grp_barrier(xb);
}
template <class Epi>
__device__ __forceinline__ void small_gemm_pair(const GemmP& g0, const Epi& e0, const GemmP& g1, const Epi& e1, int it, char* smem) {
    const int half = threadIdx.x >> 8; const int t = (it & 7) * 2 + half; bf16* sm = (bf16*)(smem + half * G_SMEM);
    __syncthreads();
    if (it < 8) gemm_tile<Epi, false>(g0, e0, t, 0, sm); else gemm_tile<Epi, false>(g1, e1, t, 0, sm);
}

__global__ void __launch_bounds__(512) mega_kernel(MegaP P) {
    __shared__ __attribute__((aligned(16))) char smem[MEGA_SMEM + 32];
    cg::grid_group grid = cg::this_grid();
    const WS& ws = P.ws; const float* const* in = P.in;
    const int G = gridDim.x, bid = blockIdx.x, tid = threadIdx.x, lane = tid & 63, w = tid >> 6;
    volatile LDS_AS unsigned* st = (volatile LDS_AS unsigned*)(smem + MEGA_SMEM);
    if (tid == 0) { st[0] = 0u; st[1] = 0u; st[2] = 0u; st[3] = 0u; }
    __syncthreads();
    const XcdBarrier xb = xcd_barrier_post(ws.bar, st);
    if (tid == 0) __hip_atomic_fetch_or(&ws.bar[GB_MASK(bid & 7)], 1u << xb.x, __ATOMIC_RELAXED, __HIP_MEMORY_SCOPE_AGENT);
    cvt_all<1, true>(in[3], in[4], FF, in[2], ws.wA1, 2 * FF, 2 * FF, D, smem, bid, G);
    cvt_all<0, false>(in[5], nullptr, D, nullptr, ws.wA2, D, D, FF, smem, (bid + 64) % G, G);
    cvt_all<0, true>(in[7], nullptr, EVEN_IN, in[6], ws.wt_in0, 2048, 2048, D, smem, bid, G);
    cvt_all<0, false>(in[19], nullptr, D, nullptr, ws.wt_out0, D, D, D, smem, (bid + 224) % G, G);
    cvt_all<0, false>(in[16], nullptr, 512, nullptr, ws.wt_glu, 512, 512, 512, smem, (bid + 96) % G, G);
    for (int oc = bid; oc < 256; oc += G) {
        const int which = oc >> 7, n = oc & 127; const float* pe = which ? in[35] : in[34]; const float* w1 = which ? in[38] : in[36]; float sacc = 0.f;
#pragma unroll
        for (int i = 0; i < 4; ++i) { const int k = tid + i * 512; sacc += pe[k] * w1[(size_t)k * 128 + n]; }
        for (int o = 32; o; o >>= 1) sacc += __shfl_xor(sacc, o);
        float* red = (float*)smem; __syncthreads(); if (lane == 0) red[w] = sacc; __syncthreads();
        if (tid == 0) ws.cb1[oc] = ((red[0] + red[1]) + (red[2] + red[3])) + ((red[4] + red[5]) + (red[6] + red[7])); }
    if (bid == 0 && tid < 128) { const int n = tid; int b_; if (n < 16) b_ = n; else { const float v = logf((float)n / 16.0f) / 2.0794415416798357f * 16.0f; b_ = 16 + (int)v; if (b_ > 31) b_ = 31; } ws.bkt[n] = b_;
#pragma unroll
        for (int hq = 0; hq < 8; ++hq) ws.tbg[hq * 128 + n] = in[1][b_ * 8 + hq] * LOG2E; }
    for (int row0 = bid * 8 + w; row0 < T; row0 += G * 8 * 4) {
        f32x4 xv[4][4];
#pragma unroll
        for (int j = 0; j < 4; ++j) { int row = row0 + j * G * 8; row = row < T ? row : row0;
#pragma unroll
            for (int i = 0; i < 4; ++i) xv[j][i] = *(const f32x4*)(in[0] + (size_t)row * D + i * 256 + lane * 4); }
#pragma unroll
        for (int j = 0; j < 4; ++j) { const int row = row0 + j * G * 8; if (row < T) { float s = 0.f;
#pragma unroll
            for (int i = 0; i < 4; ++i) { const f32x4 v = xv[j][i]; *(uint2*)(ws.hb + (size_t)row * D + i * 256 + lane * 4) = pk4(v); s += v[0] * v[0] + v[1] * v[1] + v[2] * v[2] + v[3] * v[3]; }
            for (int o = 32; o; o >>= 1) s += __shfl_xor(s, o);
            if (lane < 4) ws.ssq[(size_t)row * 4 + lane] = lane == 0 ? s : 0.f; } } }
    xcd_barrier(xb);
    grid.sync();
    if (tid == 0) { const unsigned mk = xb_ld(&ws.bar[GB_MASK(bid & 7)]); st[2] = (__builtin_popcount(mk) == 1) ? 1u : 0u; }
    ffn_phases(P, ws.wA1, ws.wA2, smem, bid, G, xb, 20, ws.wB1, ws.wB2);
    big_gemm<EpiWin0, false>(ws.hb, D, ws.wt_in0, T, 2048, D, EpiWin0{ws.u0, ws.qkv0, ws.ssq}, smem, G, bid);
    {
        __syncthreads();
        constexpr int WST = 1040; bf16* wf = (bf16*)smem;
        for (int k = tid; k < 1024; k += 512) { const f32x4 w0 = *(const f32x4*)(in[7] + (size_t)k * EVEN_IN + 2048), w1 = *(const f32x4*)(in[7] + (size_t)k * EVEN_IN + 2052); const float gk = in[6][k];
#pragma unroll
            for (int j = 0; j < 4; ++j) { wf[j * WST + k] = f2bf(w0[j] * gk); wf[(4 + j) * WST + k] = f2bf(w1[j] * gk); wf[(8 + j) * WST + k] = (bf16)0; wf[(12 + j) * WST + k] = (bf16)0; } }
        __syncthreads();
        if (w < 4) { const int l15 = lane & 15, quad = lane >> 4; const int row0 = ((8 * (bid & 7) + (bid >> 5)) * 256 + ((bid >> 3) & 3) * 64) + w * 16;
            f32x4 acc0 = {0.f, 0.f, 0.f, 0.f}, acc1 = {0.f, 0.f, 0.f, 0.f};
            const bf16* ap = ws.hb + (size_t)(row0 + l15) * D + quad * 8; const bf16* bp = wf + l15 * WST + quad * 8;
#pragma unroll 4
            for (int ks = 0; ks < 32; ks += 2) {
                const bf16x8 a0 = *(const bf16x8*)(ap + ks * 32), a1 = *(const bf16x8*)(ap + ks * 32 + 32);
                const bf16x8 b0 = *(const bf16x8*)(bp + ks * 32), b1 = *(const bf16x8*)(bp + ks * 32 + 32);
                acc0 = __builtin_amdgcn_mfma_f32_16x16x32_bf16(a0, b0, acc0, 0, 0, 0); acc1 = __builtin_amdgcn_mfma_f32_16x16x32_bf16(a1, b1, acc1, 0, 0, 0); }
            const f32x4 acc = acc0 + acc1;
            if (l15 < 8) {
#pragma unroll
                for (int r = 0; r < 4; ++r) { const int row = row0 + quad * 4 + r; ws.flog[(size_t)row * 8 + l15] = acc[r] * rstd4(ws.ssq, row); } }
        }
    }
    grp_barrier(xb);
    const S5P sp{ws.u0, in[8], in[9], in[10], in[11], in[12], in[13], in[14], in[15], ws.s5e, ws.hg};
    const int ogx = bid & 7, ogj = bid >> 3;
    const int s5it = (((ogx >> 2) * 32 + ogj) << 2) + (ogx & 3);
    if (ogj < 2) { foxcum_block(ws.flog, in[18], ws.cum, ws.segtot, (ogx >> 2) * 8 + (ogx & 3) * 2 + ogj, smem); __syncthreads(); }
    s5_item<false>(sp, s5it, smem);
    xcd_barrier(xb);
    { AttnP a{}; a.q = ws.qkv0; a.ldq = 1536; a.k = ws.qkv0 + 512; a.ldk = 1536; a.v = ws.qkv0 + 1024; a.ldv = 1536; a.cum = ws.cum; a.segtot = ws.segtot; a.out = ws.ycat + 512; a.ldo = D;
      const int fp = 8 * ogx + (ogj & 7), fi = (31 - (fp & 31)) * 16 + (fp >> 5) * 8 + (ogj >> 3);
      __syncthreads(); flash_item<0>(a, fi, smem);
      __syncthreads(); flash_item<0>(a, fi + 4, smem);
      __syncthreads(); s5_item<true>(sp, s5it, smem); }
    grp_barrier(xb);
    big_gemm<EpiGlu, false>(ws.hg, 512, ws.wt_glu, T, 512, 512, EpiGlu{ws.hg, in[17], ws.ycat}, smem, G, bid);
    if (bid >= G / 2) {
        const int vb = bid - G / 2, VG = G - G / 2;
        __syncthreads();
        cvt_all<3, true>(in[29], nullptr, ODD_IN, in[28], ws.wt_in1, 2048, ODD_IN, D, smem, vb, VG);
        cvt_all<2, true>(in[31], nullptr, 768, in[30], ws.wt_uq, 768, 768, 384, smem, vb, VG);
        cvt_all<4, false>(in[36], nullptr, 128, nullptr, ws.wt_c1k, 256, 256, 1024, smem, vb, VG);
        cvt_all<4, false>(in[38], nullptr, 128, nullptr, ws.wt_c1v, 256, 256, 1024, smem, vb, VG);
        cvt_all<0, true>(in[33], nullptr, 1024, in[32], ws.wt_ukv, 1024, 1024, 256, smem, vb, VG);
        cvt_all<0, false>(in[41], nullptr, D, nullptr, ws.wt_out1, D, D, D, smem, vb, VG);
        for (int i = vb * 512 + tid; i < S * 16; i += VG * 512) { const int pos = i >> 4, k = i & 15; const float fr = powf(10000.0f, -(float)k / 16.0f), ang = (float)pos * fr; ws.ropet[2 * i] = cosf(ang); ws.ropet[2 * i + 1] = sinf(ang); }
    }
    grp_barrier(xb);
    res_gemm(ws.ycat, D, ws.wt_out0, D, EpiRes{nullptr, nullptr, ws.hb, ws.ssq, nullptr, nullptr, 1.0f, 0}, smem, G, bid);
    grp_barrier(xb);
    ffn_phases(P, ws.wB1, ws.wB2, smem, bid, G, xb, 24, ws.wA1, ws.wA2, nullptr, nullptr, true);
    ffn_phases(P, ws.wA1, ws.wA2, smem, bid, G, xb, 42, ws.wB1, ws.wB2);
    big_gemm<EpiWin1, false>(ws.hb, D, ws.wt_in1, T, 2048, D, EpiWin1{ws.w1o, ws.ssq, ws.ssq1, ws.ropet, ws.hkv}, smem, G, bid);
    xcd_barrier(xb);
    {
        big_gemm<EpiPQ, false>(ws.hkv, 1024, ws.wt_c1k, 2048, 256, 1024, EpiPQ{ws.pq}, smem, G, bid);
        big_gemm<EpiPQ, false>(ws.hkv + (size_t)2048 * 1024, 1024, ws.wt_c1v, 2048, 256, 1024, EpiPQ{ws.pq + (size_t)2048 * 256}, smem, G, (bid + G - 8) % G);
        big_gemm<EpiUq, false>(ws.w1o + C_CQ, LDW1, ws.wt_uq, T, 768, 384, EpiUq{ws.qmla, ws.ssq1, ws.ropet}, smem, G, (bid + G - 16) % G);
        if (bid >= 16) big_gemm<EpiUkv, false>(ws.w1o + C_CKV, LDW1, ws.wt_ukv, T, 1024, 256, EpiUkv{ws.kvmla, ws.ssq1}, smem, G - 16, bid >= 208 ? bid - 208 : bid + 32);
    }
    xcd_barrier(xb);
    {   GemmP gk{}; gk.amode = 2; gk.PQ = ws.pq; gk.cb1 = ws.cb1; gk.lda = 128; gk.W = in[37]; gk.ldw = 64; gk.M = 2048; gk.N = 64; gk.K = 128;
        GemmP gv = gk; gv.PQ = ws.pq + (size_t)2048 * 256; gv.cb1 = ws.cb1 + 128; gv.W = in[39];
        const GemmP gq = (bid >> 7) ? gv : gk; bf16* outb = (bid >> 7) ? ws.vcb : ws.kcb; const int r0 = (bid & 127) * 16;
        constexpr int WS2 = 144; bf16* wl = (bf16*)smem;
        __syncthreads();
        for (int e = tid; e < 128 * 16; e += 512) { const int k = e >> 4, n4 = (e & 15) * 4; const f32x4 wv = *(const f32x4*)(gq.W + (size_t)k * 64 + n4);
#pragma unroll
            for (int i = 0; i < 4; ++i) wl[(n4 + i) * WS2 + k] = f2bf(wv[i]); }
        __syncthreads();
        if (w == 0) { const int l15 = lane & 15, quad = lane >> 4, m = r0 + l15; const bool ok = a_valid(gq, m);
            f32x4 acc[4];
#pragma unroll
            for (int nt = 0; nt < 4; ++nt) acc[nt] = (f32x4){0.f, 0.f, 0.f, 0.f};
#pragma unroll
            for (int ks = 0; ks < 4; ++ks) { const uint4 av = a_load8(gq, ok ? m : r0, ks * 32 + quad * 8); const u32x4 a4 = {ok ? av.x : 0u, ok ? av.y : 0u, ok ? av.z : 0u, ok ? av.w : 0u}; const bf16x8 af = __builtin_bit_cast(bf16x8, a4);
#pragma unroll
                for (int nt = 0; nt < 4; ++nt) { const bf16x8 wf = *(const bf16x8*)(wl + (nt * 16 + l15) * WS2 + ks * 32 + quad * 8); acc[nt] = __builtin_amdgcn_mfma_f32_16x16x32_bf16(wf, af, acc[nt], 0, 0, 0); } }
#pragma unroll
            for (int nt = 0; nt < 4; ++nt) *(uint2*)(outb + (size_t)m * 64 + nt * 16 + quad * 4) = pk4(acc[nt]); }
    }
    xcd_barrier(xb);
    { AttnP a{}; a.q = ws.qmla; a.ldq = 768; a.k = ws.kvmla; a.ldk = 1024; a.v = ws.kvmla; a.ldv = 1024; a.k2 = ws.w1o; a.out = ws.ycat; a.ldo = D;
      AttnP n{}; n.q = ws.w1o + C_QN; n.ldq = LDW1; n.k = ws.w1o + C_KS; n.ldk = LDW1; n.v = ws.w1o + C_VS; n.ldv = LDW1; n.kw = ws.w1o + C_KW; n.vw = ws.w1o + C_VW;
      n.relb = in[1]; n.bkt = ws.bkt; n.tbg = ws.tbg; n.gl = ws.w1o; n.bgate = in[40]; n.kcb = ws.kcb; n.vcb = ws.vcb; n.out = ws.ycat + 512; n.ldo = D;
      FOR_ITEMS(it, 512) { __syncthreads(); flash_item<1>(a, it, smem); }
      for (;;) { __syncthreads();
          if (tid == 0) st[4] = xb_add(&ws.bar[NSA_Q], 1u);
          __syncthreads();
          const int it = (int)st[4];
          if (it >= 512) break;
          nsa_item(n, it, smem); } }
    xcd_barrier(xb);
    res_gemm(ws.ycat, D, ws.wt_out1, D, EpiRes{nullptr, nullptr, ws.hb, ws.ssq, nullptr, nullptr, 1.0f, 0}, smem, G, bid);
    grp_barrier(xb);
    ffn_phases(P, ws.wB1, ws.wB2, smem, bid, G, xb, -1, nullptr, nullptr, nullptr, P.h);
}

static inline size_t al(size_t x) { return (x + 255) & ~(size_t)255; }
extern "C" void kernel_launch(void* const* d_in, const int* in_sizes, int n_in, void* d_out, int out_size, void* d_ws, size_t ws_size, hipStream_t stream) {
    MegaP P{};
    for (int i = 0; i < 47; ++i) P.in[i] = (const float*)d_in[i];
    P.h = (float*)d_out;
    char* w = (char*)d_ws; size_t off = 0; WS& ws = P.ws;
    auto take = [&](size_t bytes) { char* p = w + off; off += al(bytes); return p; };
    ws.bar = (unsigned*)take((size_t)(XCD_BAR_WORDS + 64 * 64 + GB_WORDS + Q_WORDS) * 4);
    ws.hb = (bf16*)take((size_t)T * D * 2);
    ws.ssq = (float*)take((size_t)T * 32 * 4);
    ws.ssq1 = (float*)take((size_t)T * 32 * 4);
    ws.flog = (float*)take((size_t)T * 8 * 4);
    ws.cum = (float*)take((size_t)T * 8 * 4);
    ws.segtot = (float*)take((size_t)NB * 8 * 8 * 4);
    ws.kcb = (bf16*)take((size_t)4 * 512 * 64 * 2);
    ws.vcb = (bf16*)take((size_t)4 * 512 * 64 * 2);
    ws.s5e = (float*)take((size_t)64 * S5_NC * 64 * 2 * 4);
    ws.cb1 = (float*)take(256 * 4);
    ws.bkt = (int*)take(128 * 4);
    ws.tbg = (float*)take(8 * 128 * 4);
    ws.ropet = (float*)take((size_t)S * 16 * 2 * 4);
    ws.wA1 = (bf16*)take((size_t)2 * FF * D * 2); ws.wA2 = (bf16*)take((size_t)D * FF * 2);
    ws.wB1 = (bf16*)take((size_t)2 * FF * D * 2); ws.wB2 = (bf16*)take((size_t)D * FF * 2);
    ws.wt_in0 = (bf16*)take((size_t)2048 * D * 2); ws.wt_out0 = (bf16*)take((size_t)D * D * 2); ws.wt_glu = (bf16*)take((size_t)512 * 512 * 2);
    ws.wt_in1 = (bf16*)take((size_t)2048 * D * 2); ws.wt_uq = (bf16*)take((size_t)768 * 384 * 2); ws.wt_ukv = (bf16*)take((size_t)1024 * 256 * 2); ws.wt_out1 = (bf16*)take((size_t)D * D * 2);
    ws.wt_c1k = (bf16*)take((size_t)256 * 1024 * 2); ws.wt_c1v = (bf16*)take((size_t)256 * 1024 * 2);
    ws.ycat = (bf16*)take((size_t)T * D * 2);
    ws.hkv = ws.ycat; ws.pq = (float*)((char*)ws.ycat + (size_t)2 * 2048 * 1024 * 2);
    const size_t r0 = off;
    ws.hid = (bf16*)(w + r0);
    ws.u0 = (bf16*)(w + r0); ws.qkv0 = (bf16*)(w + r0 + al((size_t)T * 512 * 2));
    ws.w1o = (bf16*)(w + r0); ws.qmla = (bf16*)(w + r0 + al((size_t)T * LDW1 * 2));
    off = r0 + al((size_t)T * FF * 2);
    ws.hg = (bf16*)(w + off); ws.kvmla = (bf16*)(w + off);
    off += al((size_t)T * 1024 * 2);
    if (off > ws_size) fprintf(stderr, "workspace too small: need %zu have %zu\n", off, ws_size);
    static int grid_blocks = 0;
    if (!grid_blocks) { int dev = 0, cus = 0, per_cu = 0; (void)hipGetDevice(&dev); (void)hipDeviceGetAttribute(&cus, hipDeviceAttributeMultiprocessorCount, dev);
        (void)hipOccupancyMaxActiveBlocksPerMultiprocessor(&per_cu, mega_kernel, 512, 0); if (per_cu < 1) per_cu = 1; grid_blocks = cus; }
    (void)hipMemsetAsync(ws.bar, 0, (size_t)(XCD_BAR_WORDS + 64 * 64 + GB_WORDS + Q_WORDS) * 4, stream);
    void* args[] = {&P};
    hipError_t e = hipLaunchCooperativeKernel((void*)mega_kernel, dim3(grid_blocks), dim3(512), args, 0, stream);
    if (e != hipSuccess) fprintf(stderr, "cooperative launch failed: %s (grid %d)\n", hipGetErrorString(e), grid_blocks);
}
```
